# Optimizing an MI355X kernel written in HIP

```python
import math
import jax, jax.numpy as jnp
from jax import lax
import numpy as np

D_MODEL = 1024
BATCH = 32
SEQ = 2048
DEPTH = 2

N_A_LAYERS = DEPTH // 2
N_B_LAYERS = DEPTH - N_A_LAYERS
D_FF = 2816
RMS_EPS = 1e-6

S5_GROUP_CH = 16
S5_GROUPS = D_MODEL // S5_GROUP_CH
S5_STATE = 64
DT_MIN = 0.001
DT_MAX = 0.1

N_HEADS = 16
HEAD_DIM = D_MODEL // N_HEADS
N_KV_HEADS = 4
Q_PER_KV = N_HEADS // N_KV_HEADS
CMP_LEN = 32
CMP_STRIDE = 16
CMP_HIDDEN = 2 * HEAD_DIM
SEL_LEN = 64
SEL_TOPN = 8
WIN = 512
WIN_QB = 128
SEL_QB = 64
N_BRANCH = 3
ATTN_SCALE = HEAD_DIM ** -0.5

NUM_BUCKETS = 32
MAX_DISTANCE = 128

NEG_INF = -1e30
BIG = 1e9

kernel_name = 'yoco_s5_nsa_macaron_trunk'


def _rmsnorm(x, g):
    xf = x.astype(jnp.float32)
    y = xf * lax.rsqrt(jnp.mean(xf * xf, axis=-1, keepdims=True) + RMS_EPS)
    return (y * g.astype(jnp.float32)).astype(x.dtype)


def _swiglu(x, w_in, w_out):
    a, b = jnp.split(x @ w_in, 2, axis=-1)
    return (jax.nn.silu(a) * b) @ w_out


def _rel_bucket(dist):
    n = jnp.maximum(dist, 0)
    max_exact = NUM_BUCKETS // 2
    logv = jnp.log(jnp.maximum(n, 1).astype(jnp.float32) / max_exact) / math.log(MAX_DISTANCE / max_exact)
    large = jnp.minimum(max_exact + (logv * (NUM_BUCKETS - max_exact)).astype(jnp.int32), NUM_BUCKETS - 1)
    return jnp.where(n < max_exact, n, large)


def _masked_softmax(logits, mask):
    return jax.nn.softmax(jnp.where(mask, logits, NEG_INF), axis=-1)


def _s5_mixer(u, a_re, a_im, log_dt, b_re, b_im, c_re, c_im, d_skip, w_glu):
    bsz, seq, _ = u.shape
    ug = u.reshape(bsz, seq, S5_GROUPS, S5_GROUP_CH)
    dt = jnp.exp(log_dt)[:, None]
    mag = jnp.exp(a_re * dt)
    ab_re = mag * jnp.cos(a_im * dt)
    ab_im = mag * jnp.sin(a_im * dt)
    den = a_re * a_re + a_im * a_im
    z_re = ((ab_re - 1.0) * a_re + ab_im * a_im) / den
    z_im = (ab_im * a_re - (ab_re - 1.0) * a_im) / den
    bb_re = z_re[..., None] * b_re - z_im[..., None] * b_im
    bb_im = z_re[..., None] * b_im + z_im[..., None] * b_re
    bu_re = jnp.einsum('bsgh,gph->bsgp', ug, bb_re)
    bu_im = jnp.einsum('bsgh,gph->bsgp', ug, bb_im)
    shape = (1, seq, S5_GROUPS, S5_STATE)
    la_re = jnp.broadcast_to(ab_re, shape)
    la_im = jnp.broadcast_to(ab_im, shape)

    def combine(e1, e2):
        ar1, ai1, br1, bi1 = e1
        ar2, ai2, br2, bi2 = e2
        return (ar2 * ar1 - ai2 * ai1,
                ar2 * ai1 + ai2 * ar1,
                ar2 * br1 - ai2 * bi1 + br2,
                ar2 * bi1 + ai2 * br1 + bi2)

    _, _, x_re, x_im = lax.associative_scan(combine, (la_re, la_im, bu_re, bu_im), axis=1)
    y = (jnp.einsum('bsgp,ghp->bsgh', x_re, c_re) - jnp.einsum('bsgp,ghp->bsgh', x_im, c_im)
         + d_skip * ug)
    y = jax.nn.gelu(y.reshape(bsz, seq, D_MODEL))
    return y * jax.nn.sigmoid(y @ w_glu)


def _shared_kv(h, kv_norm, w_kv, k_norm_cmp, k_norm_slc, k_norm_win,
               cmp_pos_k, cmp_pos_v, cmp_k_w1, cmp_k_w2, cmp_v_w1, cmp_v_w2):
    bsz, seq, _ = h.shape
    kv = (_rmsnorm(h, kv_norm) @ w_kv).reshape(bsz, seq, 2 * N_BRANCH, N_KV_HEADS, HEAD_DIM)
    n_cmp = (seq - CMP_LEN) // CMP_STRIDE + 1
    blk = jnp.arange(n_cmp)[:, None] * CMP_STRIDE + jnp.arange(CMP_LEN)[None, :]

    def compress(src, pos, w1, w2):
        blocks = src[:, blk] + pos[None, None, :, None, :]
        hid = jax.nn.gelu(jnp.einsum('bclgd,ldh->bcgh', blocks, w1))
        return jnp.einsum('bcgh,hd->bcgd', hid, w2)

    k_cmp = _rmsnorm(compress(kv[:, :, 0], cmp_pos_k, cmp_k_w1, cmp_k_w2), k_norm_cmp)
    v_cmp = compress(kv[:, :, 1], cmp_pos_v, cmp_v_w1, cmp_v_w2)
    k_slc = _rmsnorm(kv[:, :, 2], k_norm_slc)
    v_slc = kv[:, :, 3]
    k_win = _rmsnorm(kv[:, :, 4], k_norm_win)
    v_win = kv[:, :, 5]
    return (k_cmp, v_cmp, k_slc, v_slc, k_win, v_win)


def _compressed_branch(q, k_cmp, v_cmp, rel_bias):
    seq = q.shape[1]
    n_cmp = k_cmp.shape[1]
    n_sel = seq // SEL_LEN
    t = jnp.arange(seq)
    c_start = jnp.arange(n_cmp) * CMP_STRIDE
    dist = t[:, None] - (c_start + CMP_LEN - 1)[None, :]
    valid = dist >= 0
    bias = rel_bias[_rel_bucket(dist)].transpose(2, 0, 1).reshape(N_KV_HEADS, Q_PER_KV, seq, n_cmp)
    logits = jnp.einsum('bsgrd,bcgd->bgrsc', q, k_cmp).astype(jnp.float32) * ATTN_SCALE + bias
    p = _masked_softmax(logits, valid) * jnp.any(valid, axis=-1)[:, None].astype(jnp.float32)
    o = jnp.einsum('bgrsc,bcgd->bsgrd', p.astype(v_cmp.dtype), v_cmp)
    j_start = jnp.arange(n_sel) * SEL_LEN
    ov = jnp.clip(jnp.minimum(c_start[:, None] + CMP_LEN, j_start[None, :] + SEL_LEN)
                  - jnp.maximum(c_start[:, None], j_start[None, :]), 0, None)
    overlap = ov.astype(jnp.float32) / CMP_LEN
    p_slc = jnp.einsum('bgrsc,cj->bgsj', p, overlap)
    return o, p_slc


def _select_blocks(p_slc):
    seq, n_sel = p_slc.shape[2], p_slc.shape[3]
    k = min(SEL_TOPN, n_sel)
    t = jnp.arange(seq)[:, None]
    j = jnp.arange(n_sel)[None, :]
    cur = t // SEL_LEN
    forced = (j == 0) | (j == cur) | (j == cur - 1)
    causal = j * SEL_LEN <= t
    score = jnp.where(forced, BIG, jnp.where(causal, p_slc, -BIG))
    _, idx = lax.top_k(score, k)
    return idx


def _selected_branch(q, k_slc, v_slc, idx, rel_bias):
    bsz, seq = q.shape[0], q.shape[1]
    n_top = idx.shape[-1]
    kl = n_top * SEL_LEN
    n_ch = seq // SEL_QB
    kst = k_slc.transpose(0, 2, 1, 3)
    vst = v_slc.transpose(0, 2, 1, 3)
    table = rel_bias.reshape(NUM_BUCKETS, N_KV_HEADS, Q_PER_KV).transpose(1, 0, 2)
    gather = jax.vmap(jax.vmap(lambda a, i: a[i]))
    qc = q.reshape(bsz, n_ch, SEL_QB, N_KV_HEADS, Q_PER_KV, HEAD_DIM).transpose(1, 0, 2, 3, 4, 5)
    ic = idx.reshape(bsz, N_KV_HEADS, n_ch, SEL_QB, n_top).transpose(2, 0, 1, 3, 4)

    def step(args):
        ci, qb, ib = args
        tok = (ib[..., None] * SEL_LEN + jnp.arange(SEL_LEN)).reshape(bsz, N_KV_HEADS, SEL_QB * kl)
        kg = gather(kst, tok).reshape(bsz, N_KV_HEADS, SEL_QB, kl, HEAD_DIM)
        vg = gather(vst, tok).reshape(bsz, N_KV_HEADS, SEL_QB, kl, HEAD_DIM)
        tok = tok.reshape(bsz, N_KV_HEADS, SEL_QB, kl)
        qpos = ci * SEL_QB + jnp.arange(SEL_QB)
        dist = qpos[None, None, :, None] - tok
        bias = table[jnp.arange(N_KV_HEADS)[None, :, None, None], _rel_bucket(dist)]
        logits = (jnp.einsum('bqgrd,bgqkd->bgrqk', qb, kg).astype(jnp.float32) * ATTN_SCALE
                  + bias.transpose(0, 1, 4, 2, 3))
        p = _masked_softmax(logits, (dist >= 0)[:, :, None])
        return jnp.einsum('bgrqk,bgqkd->bqgrd', p.astype(vg.dtype), vg)

    out = lax.map(step, (jnp.arange(n_ch), qc, ic))
    return out.transpose(1, 0, 2, 3, 4, 5).reshape(bsz, seq, N_KV_HEADS, Q_PER_KV, HEAD_DIM)


def _window_branch(q, k_win, v_win, rel_bias):
    bsz, seq = q.shape[0], q.shape[1]
    n_blk = seq // WIN_QB
    span = WIN + WIN_QB
    kp = jnp.pad(k_win, ((0, 0), (WIN, 0), (0, 0), (0, 0)))
    vp = jnp.pad(v_win, ((0, 0), (WIN, 0), (0, 0), (0, 0)))
    dist = WIN + jnp.arange(WIN_QB)[:, None] - jnp.arange(span)[None, :]
    band = (dist >= 0) & (dist < WIN)
    bias = rel_bias[_rel_bucket(dist)].transpose(2, 0, 1).reshape(N_KV_HEADS, Q_PER_KV, WIN_QB, span)
    qb_all = q.reshape(bsz, n_blk, WIN_QB, N_KV_HEADS, Q_PER_KV, HEAD_DIM).transpose(1, 0, 2, 3, 4, 5)

    def step(args):
        bi, qb = args
        start = bi * WIN_QB
        kb = lax.dynamic_slice_in_dim(kp, start, span, axis=1)
        vb = lax.dynamic_slice_in_dim(vp, start, span, axis=1)
        kpos = start - WIN + jnp.arange(span)
        mask = band & (kpos >= 0)[None, :]
        logits = jnp.einsum('bqgrd,bkgd->bgrqk', qb, kb).astype(jnp.float32) * ATTN_SCALE + bias
        p = _masked_softmax(logits, mask)
        return jnp.einsum('bgrqk,bkgd->bqgrd', p.astype(vb.dtype), vb)

    out = lax.map(step, (jnp.arange(n_blk), qb_all))
    return out.transpose(1, 0, 2, 3, 4, 5).reshape(bsz, seq, N_KV_HEADS, Q_PER_KV, HEAD_DIM)


def _nsa_mixer(u, kv, w_qg, q_norm, w_o, rel_bias):
    k_cmp, v_cmp, k_slc, v_slc, k_win, v_win = kv
    bsz, seq, _ = u.shape
    qg = u @ w_qg
    q = _rmsnorm(qg[..., :N_HEADS * HEAD_DIM].reshape(bsz, seq, N_KV_HEADS, Q_PER_KV, HEAD_DIM), q_norm)
    gates = jax.nn.sigmoid(qg[..., N_HEADS * HEAD_DIM:].reshape(bsz, seq, N_KV_HEADS, Q_PER_KV, N_BRANCH))
    o_cmp, p_slc = _compressed_branch(q, k_cmp, v_cmp, rel_bias)
    idx = _select_blocks(p_slc)
    o_slc = _selected_branch(q, k_slc, v_slc, idx, rel_bias)
    o_win = _window_branch(q, k_win, v_win, rel_bias)
    o = gates[..., 0:1] * o_cmp + gates[..., 1:2] * o_slc + gates[..., 2:3] * o_win
    return o.reshape(bsz, seq, D_MODEL) @ w_o


def setup_inputs(seed: int = 0) -> dict:
    key = jax.random.key(seed)
    ks = iter(jax.random.split(key, 40))

    def nrm(shape, scale):
        return jax.random.normal(next(ks), shape, jnp.float32) * scale

    def gain(shape):
        return 1.0 + nrm(shape, 0.02)

    na, nb = N_A_LAYERS, N_B_LAYERS
    g, p, ch = S5_GROUPS, S5_STATE, S5_GROUP_CH
    return {
        'x': nrm((BATCH, SEQ, D_MODEL), 1.0),
        'rel_bias': nrm((NUM_BUCKETS, N_HEADS), 0.5),
        'ffn1_norm': gain((DEPTH, D_MODEL)),
        'ffn1_w_in': nrm((DEPTH, D_MODEL, 2 * D_FF), D_MODEL ** -0.5),
        'ffn1_w_out': nrm((DEPTH, D_FF, D_MODEL), D_FF ** -0.5),
        'mix_norm': gain((DEPTH, D_MODEL)),
        'ffn2_norm': gain((DEPTH, D_MODEL)),
        'ffn2_w_in': nrm((DEPTH, D_MODEL, 2 * D_FF), D_MODEL ** -0.5),
        'ffn2_w_out': nrm((DEPTH, D_FF, D_MODEL), D_FF ** -0.5),
        's5_a_re': -0.5 + nrm((na, g, p), 0.01),
        's5_a_im': jnp.pi * jnp.arange(p, dtype=jnp.float32)[None, None, :] + nrm((na, g, p), 0.01),
        's5_log_dt': jax.random.uniform(next(ks), (na, g), jnp.float32, math.log(DT_MIN), math.log(DT_MAX)),
        's5_b_re': nrm((na, g, p, ch), (2.0 * ch) ** -0.5),
        's5_b_im': nrm((na, g, p, ch), (2.0 * ch) ** -0.5),
        's5_c_re': nrm((na, g, ch, p), (2.0 * p) ** -0.5),
        's5_c_im': nrm((na, g, ch, p), (2.0 * p) ** -0.5),
        's5_d': nrm((na, g, ch), 1.0),
        's5_w_glu': nrm((na, D_MODEL, D_MODEL), D_MODEL ** -0.5),
        'kv_norm': gain((D_MODEL,)),
        'w_kv': nrm((D_MODEL, 2 * N_BRANCH * N_KV_HEADS * HEAD_DIM), D_MODEL ** -0.5),
        'k_norm_cmp': gain((HEAD_DIM,)),
        'k_norm_slc': gain((HEAD_DIM,)),
        'k_norm_win': gain((HEAD_DIM,)),
        'cmp_pos_k': nrm((CMP_LEN, HEAD_DIM), 0.1),
        'cmp_pos_v': nrm((CMP_LEN, HEAD_DIM), 0.1),
        'cmp_k_w1': nrm((CMP_LEN, HEAD_DIM, CMP_HIDDEN), (CMP_LEN * HEAD_DIM) ** -0.5),
        'cmp_k_w2': nrm((CMP_HIDDEN, HEAD_DIM), CMP_HIDDEN ** -0.5),
        'cmp_v_w1': nrm((CMP_LEN, HEAD_DIM, CMP_HIDDEN), (CMP_LEN * HEAD_DIM) ** -0.5),
        'cmp_v_w2': nrm((CMP_HIDDEN, HEAD_DIM), CMP_HIDDEN ** -0.5),
        'w_qg': nrm((nb, D_MODEL, N_HEADS * HEAD_DIM + N_BRANCH * N_HEADS), D_MODEL ** -0.5),
        'q_norm': gain((nb, HEAD_DIM)),
        'w_o': nrm((nb, D_MODEL, D_MODEL), D_MODEL ** -0.5),
    }


def reference(x, rel_bias, ffn1_norm, ffn1_w_in, ffn1_w_out, mix_norm, ffn2_norm, ffn2_w_in, ffn2_w_out,
              s5_a_re, s5_a_im, s5_log_dt, s5_b_re, s5_b_im, s5_c_re, s5_c_im, s5_d, s5_w_glu,
              kv_norm, w_kv, k_norm_cmp, k_norm_slc, k_norm_win, cmp_pos_k, cmp_pos_v,
              cmp_k_w1, cmp_k_w2, cmp_v_w1, cmp_v_w2, w_qg, q_norm, w_o):
    h = x
    kv = None
    for layer in range(DEPTH):
        h = h + 0.5 * _swiglu(_rmsnorm(h, ffn1_norm[layer]), ffn1_w_in[layer], ffn1_w_out[layer])
        u = _rmsnorm(h, mix_norm[layer])
        if layer < N_A_LAYERS:
            a = layer
            h = h + _s5_mixer(u, s5_a_re[a], s5_a_im[a], s5_log_dt[a], s5_b_re[a], s5_b_im[a],
                              s5_c_re[a], s5_c_im[a], s5_d[a], s5_w_glu[a])
        else:
            b = layer - N_A_LAYERS
            h = h + _nsa_mixer(u, kv, w_qg[b], q_norm[b], w_o[b], rel_bias)
        h = h + 0.5 * _swiglu(_rmsnorm(h, ffn2_norm[layer]), ffn2_w_in[layer], ffn2_w_out[layer])
        if layer == N_A_LAYERS - 1:
            kv = _shared_kv(h, kv_norm, w_kv, k_norm_cmp, k_norm_slc, k_norm_win,
                            cmp_pos_k, cmp_pos_v, cmp_k_w1, cmp_k_w2, cmp_v_w1, cmp_v_w2)
    return h
```

```cpp
#include <hip/hip_runtime.h>
#include <hip/hip_cooperative_groups.h>
#include <cstdio>
#include <cstdint>
namespace cg = cooperative_groups;
namespace pg8 {
#define PG8_LAS __attribute__((address_space(3)))
typedef unsigned short bf16_t;
typedef short bf16x8 __attribute__((ext_vector_type(8)));
typedef float f32x4 __attribute__((ext_vector_type(4)));
typedef unsigned u32x4 __attribute__((ext_vector_type(4)));
constexpr int BM = 256, BK = 64, HALF = 128, HTB = HALF * BK * 2  , STAGE_BYTES = 8 * HTB, NXCD = 8, WGM = 8;

__host__ __device__ __forceinline__ int lds_byte(int r, int c) { const int st = (r >> 4) * 2 + (c >> 5), rr = r & 15, cc = c & 31, ob = rr * 64 + cc * 2; return st * 1024 + (ob ^ (((ob >> 9) & 1) << 5)); }
__host__ __device__ __forceinline__ void stage_rc(int b, int& R, int& C) { const int st = b / 1024, sb = b % 1024, swz = sb ^ (((sb >> 9) & 1) << 5); R = (st >> 1) * 16 + swz / 64; C = (st & 1) * 32 + (swz % 64) / 2; }
__host__ __device__ __forceinline__ int perm32(int rho) { const int n = rho >> 4, i = rho & 15; return 8 * (i >> 2) + 4 * n + (i & 3); }

struct Unit { int pm, pn; };
struct Gemm { const bf16_t* A; const bf16_t* Bt; int M, N, K; int a_tiled; };

struct StaticOrder {
    int nM, nN, nwg, G, c, pm0;
    __host__ __device__ void init(int M, int N, int G_, int c_, int pm0_ = 0) { nM = M / BM; nN = N / BM; nwg = nM * nN; G = G_; c = c_; pm0 = pm0_; }
    __host__ __device__ bool next(int i, Unit& u) const {
        const long L = (long)i * G + c; if (L >= nwg) return false;
        int wgid = (int)L; { const int q = nwg / NXCD, r = nwg % NXCD, xcd = wgid % NXCD, off = wgid / NXCD; wgid = (xcd < r ? xcd * (q + 1) : r * (q + 1) + (xcd - r) * q) + off; }
        const int nig = WGM * nN, gid = wgid / nig, fm = gid * WGM, gsz = (nM - fm) < WGM ? (nM - fm) : WGM;
        u.pm = pm0 + fm + ((wgid % nig) % gsz); u.pn = (wgid % nig) / gsz; return true;
    }
    __device__ __forceinline__ void a_ready(const Unit&) const {}
    __device__ __forceinline__ void done(const Unit&) const {}
};

__device__ __forceinline__ unsigned cvt_pk_bf16(float lo, float hi) { unsigned r; asm volatile("v_cvt_pk_bf16_f32 %0, %1, %2" : "=v"(r) : "v"(lo), "v"(hi)); return r; }
typedef float f32x2 __attribute__((ext_vector_type(2)));
__device__ __forceinline__ float sigmoidf_(float a) { return __builtin_amdgcn_rcpf(1.0f + __expf(-a)); }
__device__ __forceinline__ float row_rstd(const float* rp, int row) {
    const f32x4 a = *(const f32x4*)(rp + (size_t)row * 4);
    const float s = (a[0] + a[1]) + (a[2] + a[3]);
    return __builtin_amdgcn_rsqf(s * (1.0f / 1024.0f) + 1e-6f);
}
struct EpiSwiglu {
    static constexpr bool PERM = true, AFTER_DRAIN = false;
    bf16_t* O; int ldc; const float* rp;
    __device__ __forceinline__ void operator()(const f32x4 (&acc)[2][2][4][2], const Unit& u, int wr, int wc, int fr, int fq) const {
        const int row0 = u.pm * BM + wr * 64 + fr; const int rl0 = wr * 64 + fr;
        bf16_t* tbase = O + ((size_t)u.pm * (ldc / BK) + (size_t)(u.pn * 2 + (wc >> 1))) * (BM * BK) + (wc & 1) * 32 + 8 * fq;
        f32x4 rpv[2][4];
#pragma unroll
        for (int ai = 0; ai < 2; ++ai)
#pragma unroll
            for (int m = 0; m < 4; ++m) rpv[ai][m] = *(const f32x4*)(rp + (size_t)(row0 + ai * HALF + m * 16) * 4);
#pragma unroll
        for (int ai = 0; ai < 2; ++ai)
#pragma unroll
            for (int m = 0; m < 4; ++m) { bf16_t* rowp = tbase + (size_t)(rl0 + ai * HALF + m * 16) * BK;
                const float rs = __builtin_amdgcn_rsqf(((rpv[ai][m][0] + rpv[ai][m][1]) + (rpv[ai][m][2] + rpv[ai][m][3])) * (1.0f / 1024.0f) + 1e-6f);
                f32x4 v[2];
#pragma unroll
                for (int n = 0; n < 2; ++n) { const f32x4 a = acc[ai][0][m][n] * rs, b = acc[ai][1][m][n] * rs;
#pragma unroll
                    for (int j = 0; j < 4; ++j) v[n][j] = a[j] * sigmoidf_(a[j]) * b[j]; }
                u32x4 w; w.x = cvt_pk_bf16(v[0][0], v[0][1]); w.y = cvt_pk_bf16(v[0][2], v[0][3]); w.z = cvt_pk_bf16(v[1][0], v[1][1]); w.w = cvt_pk_bf16(v[1][2], v[1][3]);
                *(u32x4*)rowp = w; }
    }
};
struct EpiPlain {
    static constexpr bool PERM = true, AFTER_DRAIN = false;
    bf16_t* O; int ldc; const float* rp;
    __device__ __forceinline__ void operator()(const f32x4 (&acc)[2][2][4][2], const Unit& u, int wr, int wc, int fr, int fq) const {
        const int row0 = u.pm * BM + wr * 64 + fr; const int col0 = u.pn * BM + wc * 32 + 8 * fq;
        f32x4 rpv[2][4];
#pragma unroll
        for (int ai = 0; ai < 2; ++ai)
#pragma unroll
            for (int m = 0; m < 4; ++m) rpv[ai][m] = *(const f32x4*)(rp + (size_t)(row0 + ai * HALF + m * 16) * 4);
#pragma unroll
        for (int ai = 0; ai < 2; ++ai)
#pragma unroll
            for (int m = 0; m < 4; ++m) { const int row = row0 + ai * HALF + m * 16;
                const float rs = __builtin_amdgcn_rsqf(((rpv[ai][m][0] + rpv[ai][m][1]) + (rpv[ai][m][2] + rpv[ai][m][3])) * (1.0f / 1024.0f) + 1e-6f);
#pragma unroll
                for (int bj = 0; bj < 2; ++bj) { const f32x4 v0 = acc[ai][bj][m][0] * rs, v1 = acc[ai][bj][m][1] * rs;
                    u32x4 w; w.x = cvt_pk_bf16(v0[0], v0[1]); w.y = cvt_pk_bf16(v0[2], v0[3]); w.z = cvt_pk_bf16(v1[0], v1[1]); w.w = cvt_pk_bf16(v1[2], v1[3]);
                    const int col = col0 + bj * HALF;
                    *(u32x4*)(O + ((size_t)(col >> 6) * ldc + row) * 64 + (col & 63)) = w; } }
    }
};
struct EpiQG {
    static constexpr bool PERM = true, AFTER_DRAIN = false;
    bf16_t* Q; float* gates; const float* rp;
    __device__ __forceinline__ void operator()(const f32x4 (&acc)[2][2][4][2], const Unit& u, int wr, int wc, int fr, int fq) const {
        const int row0 = u.pm * BM + wr * 64 + fr;
        if (u.pn < 4) {
            const int col0 = u.pn * BM + wc * 32 + 8 * fq;
#pragma unroll
            for (int ai = 0; ai < 2; ++ai)
#pragma unroll
                for (int m = 0; m < 4; ++m) { const int row = row0 + ai * HALF + m * 16; bf16_t* rowp = Q + (size_t)row * 1024 + col0; const float rs = row_rstd(rp, row);
#pragma unroll
                    for (int bj = 0; bj < 2; ++bj) { const f32x4 v0 = acc[ai][bj][m][0] * rs, v1 = acc[ai][bj][m][1] * rs;
                        u32x4 w; w.x = cvt_pk_bf16(v0[0], v0[1]); w.y = cvt_pk_bf16(v0[2], v0[3]); w.z = cvt_pk_bf16(v1[0], v1[1]); w.w = cvt_pk_bf16(v1[2], v1[3]);
                        *(u32x4*)(rowp + bj * HALF) = w; } }
        } else {
            const int c0 = wc * 32 + 8 * fq;
            if (c0 < 48) {
#pragma unroll
                for (int ai = 0; ai < 2; ++ai)
#pragma unroll
                    for (int m = 0; m < 4; ++m) { const int row = row0 + ai * HALF + m * 16; float* rowp = gates + (size_t)row * 48 + c0; const float rs = row_rstd(rp, row);
#pragma unroll
                        for (int n = 0; n < 2; ++n) { const f32x4 a = acc[ai][0][m][n] * rs; f32x4 o;
#pragma unroll
                            for (int j = 0; j < 4; ++j) o[j] = sigmoidf_(a[j]);
                            *(f32x4*)(rowp + 4 * n) = o; } }
            }
        }
    }
};
struct EpiResid {
    static constexpr bool PERM = false, AFTER_DRAIN = false;
    bf16_t* hb; float* rpo; float* out; float scale; int fin; PG8_LAS float* X; int tid;
    __device__ __forceinline__ void operator()(const f32x4 (&acc)[2][2][4][2], const Unit& u, int wr, int wc, int fr, int fq) const {
        typedef unsigned u32x2v __attribute__((ext_vector_type(2)));
        const int row0 = u.pm * BM + wr * 64 + fr; const int col0 = u.pn * BM + wc * 32 + 4 * fq;
#pragma unroll
        for (int ai = 0; ai < 2; ++ai) {
            u32x2v hv[4][2][2];
#pragma unroll
            for (int m = 0; m < 4; ++m)
#pragma unroll
                for (int bj = 0; bj < 2; ++bj)
#pragma unroll
                    for (int n = 0; n < 2; ++n) hv[m][bj][n] = *(const u32x2v*)(hb + (size_t)(row0 + ai * HALF + m * 16) * 1024 + col0 + bj * HALF + n * 16);
#pragma unroll
            for (int m = 0; m < 4; ++m) { const int row = row0 + ai * HALF + m * 16; const size_t off = (size_t)row * 1024 + col0; float ss = 0.f;
#pragma unroll
                for (int bj = 0; bj < 2; ++bj)
#pragma unroll
                    for (int n = 0; n < 2; ++n) { const size_t o2 = off + bj * HALF + n * 16; const u32x2v hh = hv[m][bj][n]; const f32x4 a = acc[ai][bj][m][n];
                        f32x4 r; r[0] = __uint_as_float(hh.x << 16) + scale * a[0]; r[1] = __uint_as_float(hh.x & 0xffff0000u) + scale * a[1];
                        r[2] = __uint_as_float(hh.y << 16) + scale * a[2]; r[3] = __uint_as_float(hh.y & 0xffff0000u) + scale * a[3];
                        if (fin) { *(f32x4*)(out + o2) = r; }
                        else { u32x2v w; w.x = cvt_pk_bf16(r[0], r[1]); w.y = cvt_pk_bf16(r[2], r[3]); *(u32x2v*)(hb + o2) = w;
                            const float q0 = __uint_as_float(w.x << 16), q1 = __uint_as_float(w.x & 0xffff0000u), q2 = __uint_as_float(w.y << 16), q3 = __uint_as_float(w.y & 0xffff0000u);
                            ss += (q0 * q0 + q1 * q1) + (q2 * q2 + q3 * q3); } }
                if (!fin) { ss += __shfl_xor(ss, 16); ss += __shfl_xor(ss, 32); if (fq == 0) X[(ai * HALF + wr * 64 + m * 16 + fr) * 4 + wc] = ss; } }
            asm volatile("" ::: "memory"); }
        if (!fin) { asm volatile("s_waitcnt lgkmcnt(0)" ::: "memory"); __builtin_amdgcn_s_barrier(); asm volatile("" ::: "memory");
            if (tid < 256) { const f32x4 v = *(const PG8_LAS f32x4*)(X + tid * 4); rpo[(size_t)(u.pm * BM + tid) * 4 + u.pn] = (v[0] + v[1]) + (v[2] + v[3]); } }
    }
};
struct EpiGlu {
    static constexpr bool PERM = false, AFTER_DRAIN = false;
    bf16_t* hb; const bf16_t* z; float* rpo; PG8_LAS float* X; int tid;
    __device__ __forceinline__ void operator()(const f32x4 (&acc)[2][2][4][2], const Unit& u, int wr, int wc, int fr, int fq) const {
        typedef unsigned u32x2v __attribute__((ext_vector_type(2)));
        const int row0 = u.pm * BM + wr * 64 + fr; const int col0 = u.pn * BM + wc * 32 + 4 * fq;
#pragma unroll
        for (int ai = 0; ai < 2; ++ai) {
            u32x2v hv[4][2][2], zv[4][2][2];
#pragma unroll
            for (int m = 0; m < 4; ++m)
#pragma unroll
                for (int bj = 0; bj < 2; ++bj)
#pragma unroll
                    for (int n = 0; n < 2; ++n) { const size_t o2 = (size_t)(row0 + ai * HALF + m * 16) * 1024 + col0 + bj * HALF + n * 16; hv[m][bj][n] = *(const u32x2v*)(hb + o2); zv[m][bj][n] = *(const u32x2v*)(z + o2); }
#pragma unroll
            for (int m = 0; m < 4; ++m) { const int row = row0 + ai * HALF + m * 16; const size_t off = (size_t)row * 1024 + col0; float ss = 0.f;
#pragma unroll
                for (int bj = 0; bj < 2; ++bj)
#pragma unroll
                    for (int n = 0; n < 2; ++n) { const size_t o2 = off + bj * HALF + n * 16; const u32x2v hh = hv[m][bj][n]; const u32x2v zz = zv[m][bj][n];
                        const f32x4 a = acc[ai][bj][m][n]; f32x4 r;
                        r[0] = __uint_as_float(hh.x << 16) + __uint_as_float(zz.x << 16) * sigmoidf_(a[0]); r[1] = __uint_as_float(hh.x & 0xffff0000u) + __uint_as_float(zz.x & 0xffff0000u) * sigmoidf_(a[1]);
                        r[2] = __uint_as_float(hh.y << 16) + __uint_as_float(zz.y << 16) * sigmoidf_(a[2]); r[3] = __uint_as_float(hh.y & 0xffff0000u) + __uint_as_float(zz.y & 0xffff0000u) * sigmoidf_(a[3]);
                        u32x2v w; w.x = cvt_pk_bf16(r[0], r[1]); w.y = cvt_pk_bf16(r[2], r[3]); *(u32x2v*)(hb + o2) = w;
                        const float q0 = __uint_as_float(w.x << 16), q1 = __uint_as_float(w.x & 0xffff0000u), q2 = __uint_as_float(w.y << 16), q3 = __uint_as_float(w.y & 0xffff0000u);
                        ss += (q0 * q0 + q1 * q1) + (q2 * q2 + q3 * q3); }
                ss += __shfl_xor(ss, 16); ss += __shfl_xor(ss, 32); if (fq == 0) X[(ai * HALF + wr * 64 + m * 16 + fr) * 4 + wc] = ss; }
            asm volatile("" ::: "memory"); }
        asm volatile("s_waitcnt lgkmcnt(0)" ::: "memory"); __builtin_amdgcn_s_barrier(); asm volatile("" ::: "memory");
        if (tid < 256) { const f32x4 v = *(const PG8_LAS f32x4*)(X + tid * 4); rpo[(size_t)(u.pm * BM + tid) * 4 + u.pn] = (v[0] + v[1]) + (v[2] + v[3]); }
    }
};
template <class Epi, class Sched, bool ALIGN_EPI = false, bool SP2 = false>
__device__ __forceinline__ void gemm_phase(PG8_LAS unsigned char* lds, const Gemm g, const Sched& S, const Epi& E, const int tid) {
    const int wid = __builtin_amdgcn_readfirstlane(tid >> 6), lane = tid & 63, wr = wid >> 2, wc = wid & 3, fr = lane & 15, fq = lane >> 4;
    const int K = g.K, nt = K / BK;
    unsigned voffA[2], voffB[2];
#pragma unroll
    for (int i = 0; i < 2; ++i) { int R, C; stage_rc(tid * 16 + i * 8192, R, C); const int Rb = Epi::PERM ? ((R & ~31) + perm32(R & 31)) : R;
        voffA[i] = (unsigned)(R * (g.a_tiled ? BK : K) + C) * 2u; voffB[i] = (unsigned)(Rb * K + C) * 2u; }
    const size_t kstepB = (size_t)(BK * 2), hstepB = (size_t)HALF * K * 2, tstepB = 2 * hstepB;
    const size_t kstepA = g.a_tiled ? (size_t)(BM * BK * 2) : kstepB, hstepA = g.a_tiled ? (size_t)(HALF * BK * 2) : hstepB, tstepA = g.a_tiled ? (size_t)nt * (BM * BK * 2) : tstepB;
    const unsigned ldsw = (unsigned)wid * 1024u;
    const int aoff = lds_byte(wr * 64 + fr, fq * 8), boff = lds_byte(wc * 32 + fr, fq * 8);
#define PG8_SA(b, h) (((b) * 2 + (h)) * HTB)
#define PG8_SB(b, h) ((4 + (b) * 2 + (h)) * HTB)
#define PG8_STAGE(bufoff, gbase, voff) do { _Pragma("unroll") for (int _i = 0; _i < 2; ++_i) \
        __builtin_amdgcn_global_load_lds((const unsigned*)((const char*)(gbase) + (voff)[_i]), (PG8_LAS unsigned*)(lds + (bufoff) + ldsw + _i * 8192), 16, 0, 0); } while (0)
#define PG8_LDA(dst, b, h) do { _Pragma("unroll") for (int m = 0; m < 4; ++m) _Pragma("unroll") for (int k = 0; k < 2; ++k) dst[m][k] = *(const PG8_LAS bf16x8*)(lds + PG8_SA(b, h) + aoff + m * 2048 + k * 1024); } while (0)
#define PG8_LDB(dst, b, h) do { _Pragma("unroll") for (int n = 0; n < 2; ++n) _Pragma("unroll") for (int k = 0; k < 2; ++k) dst[n][k] = *(const PG8_LAS bf16x8*)(lds + PG8_SB(b, h) + boff + n * 2048 + k * 1024); } while (0)
#define PG8_MMA(ai, bj, At, Bt) do { __builtin_amdgcn_s_setprio(1); _Pragma("unroll") for (int m = 0; m < 4; ++m) _Pragma("unroll") for (int n = 0; n < 2; ++n) _Pragma("unroll") for (int k = 0; k < 2; ++k) \
        acc[ai][bj][m][n] = __builtin_amdgcn_mfma_f32_16x16x32_bf16(Bt[n][k], At[m][k], acc[ai][bj][m][n], 0, 0, 0); __builtin_amdgcn_s_setprio(0); } while (0)
#define PG8_WAIT_V(n) asm volatile("s_waitcnt vmcnt(" #n ")" ::: "memory")
#define PG8_WAIT_L(n) asm volatile("s_waitcnt lgkmcnt(" #n ")" ::: "memory")
#define PG8_BAR __builtin_amdgcn_s_barrier()
#define PG8_SCHED __builtin_amdgcn_sched_barrier(0)
    Unit cur, nxt; int ui = 0;
    if (!S.next(0, cur)) return;
    f32x4 acc[2][2][4][2];
#pragma unroll
    for (int a = 0; a < 2; ++a)
#pragma unroll
        for (int b = 0; b < 2; ++b)
#pragma unroll
            for (int m = 0; m < 4; ++m)
#pragma unroll
                for (int n = 0; n < 2; ++n) acc[a][b][m][n] = (f32x4){0.f, 0.f, 0.f, 0.f};
    bf16x8 At[4][2], B0[2][2], B1[2][2];
    const char* cA = (const char*)g.A + (size_t)cur.pm * tstepA; const char* cB = (const char*)g.Bt + (size_t)cur.pn * tstepB;
    S.a_ready(cur);
    if constexpr (SP2) {
        PG8_STAGE(PG8_SB(0, 0), cB, voffB); PG8_STAGE(PG8_SB(0, 1), cB + hstepB, voffB); PG8_STAGE(PG8_SA(0, 0), cA, voffA); PG8_STAGE(PG8_SA(0, 1), cA + hstepA, voffA);
        if (wr == 1) PG8_BAR;
        PG8_WAIT_V(2); PG8_BAR;
        PG8_STAGE(PG8_SB(1, 0), cB + kstepB, voffB); PG8_STAGE(PG8_SA(1, 0), cA + kstepA, voffA); PG8_STAGE(PG8_SB(1, 1), cB + hstepB + kstepB, voffB);
        PG8_WAIT_V(6); PG8_BAR;
    } else {
        PG8_STAGE(PG8_SB(0, 0), cB, voffB); PG8_STAGE(PG8_SA(0, 0), cA, voffA); PG8_STAGE(PG8_SB(0, 1), cB + hstepB, voffB); PG8_STAGE(PG8_SA(0, 1), cA + hstepA, voffA);
        if (wr == 1) PG8_BAR;
        PG8_WAIT_V(4); PG8_BAR;
        PG8_STAGE(PG8_SB(1, 0), cB + kstepB, voffB); PG8_STAGE(PG8_SA(1, 0), cA + kstepA, voffA); PG8_STAGE(PG8_SB(1, 1), cB + hstepB + kstepB, voffB);
        PG8_WAIT_V(6); PG8_BAR;
    }
    for (;;) {
        const bool has_next = S.next(ui + 1, nxt);
        const char* nA = has_next ? (const char*)g.A + (size_t)nxt.pm * tstepA : cA; const char* nB = has_next ? (const char*)g.Bt + (size_t)nxt.pn * tstepB : cB;
        for (int t = 0; t < nt; t += 2) {
            const bool last = (t == nt - 2);
            const char* a1 = cA + (size_t)(t + 1) * kstepA;
            const char* a2 = last ? nA : cA + (size_t)(t + 2) * kstepA; const char* b2 = last ? nB : cB + (size_t)(t + 2) * kstepB;
            const char* a3 = a2 + kstepA; const char* b3 = b2 + kstepB;
            if (last && has_next) S.a_ready(nxt);
            if constexpr (SP2) {
            PG8_LDB(B0, 0, 0); PG8_LDB(B1, 0, 1); PG8_SCHED; PG8_LDA(At, 0, 0); PG8_STAGE(PG8_SA(1, 1), a1 + hstepA, voffA);
            PG8_WAIT_V(8); PG8_WAIT_L(0); PG8_BAR; PG8_MMA(0, 0, At, B0); PG8_MMA(0, 1, At, B1); PG8_BAR; PG8_SCHED;
            PG8_LDA(At, 0, 1); PG8_STAGE(PG8_SB(0, 0), b2, voffB); PG8_STAGE(PG8_SB(0, 1), b2 + hstepB, voffB); PG8_STAGE(PG8_SA(0, 0), a2, voffA);
            PG8_WAIT_V(8); PG8_WAIT_L(0); PG8_BAR; PG8_MMA(1, 0, At, B0); PG8_MMA(1, 1, At, B1); PG8_BAR; PG8_SCHED;
            PG8_LDB(B0, 1, 0); PG8_LDB(B1, 1, 1); PG8_SCHED; PG8_LDA(At, 1, 0); PG8_STAGE(PG8_SA(0, 1), a2 + hstepA, voffA);
            PG8_WAIT_V(8); PG8_WAIT_L(0); PG8_BAR; PG8_MMA(0, 0, At, B0); PG8_MMA(0, 1, At, B1); PG8_BAR; PG8_SCHED;
            PG8_LDA(At, 1, 1); PG8_STAGE(PG8_SB(1, 0), b3, voffB); PG8_STAGE(PG8_SB(1, 1), b3 + hstepB, voffB); PG8_STAGE(PG8_SA(1, 0), a3, voffA);
            PG8_WAIT_V(8); PG8_WAIT_L(0); PG8_BAR; PG8_MMA(1, 0, At, B0); PG8_MMA(1, 1, At, B1); PG8_BAR; PG8_SCHED;
            } else {
            PG8_LDB(B0, 0, 0); PG8_SCHED; PG8_LDA(At, 0, 0); PG8_STAGE(PG8_SA(1, 1), a1 + hstepA, voffA);
            PG8_WAIT_L(8); PG8_BAR; PG8_WAIT_L(0); PG8_MMA(0, 0, At, B0); PG8_BAR; PG8_SCHED;
            PG8_LDB(B1, 0, 1); PG8_STAGE(PG8_SB(0, 0), b2, voffB);
            PG8_BAR; PG8_WAIT_L(0); PG8_MMA(0, 1, At, B1); PG8_BAR;
            PG8_LDA(At, 0, 1); PG8_STAGE(PG8_SA(0, 0), a2, voffA);
            PG8_BAR; PG8_WAIT_L(0); PG8_MMA(1, 0, At, B0); PG8_BAR; PG8_SCHED;
            PG8_STAGE(PG8_SB(0, 1), b2 + hstepB, voffB);
            PG8_WAIT_V(6); PG8_BAR; PG8_MMA(1, 1, At, B1); PG8_BAR;
            PG8_LDB(B0, 1, 0); PG8_SCHED; PG8_LDA(At, 1, 0); PG8_STAGE(PG8_SA(0, 1), a2 + hstepA, voffA);
            PG8_WAIT_L(8); PG8_BAR; PG8_WAIT_L(0); PG8_MMA(0, 0, At, B0); PG8_BAR; PG8_SCHED;
            PG8_LDB(B1, 1, 1); PG8_STAGE(PG8_SB(1, 0), b3, voffB);
            PG8_BAR; PG8_WAIT_L(0); PG8_MMA(0, 1, At, B1); PG8_BAR;
            PG8_LDA(At, 1, 1); PG8_STAGE(PG8_SA(1, 0), a3, voffA);
            PG8_BAR; PG8_WAIT_L(0); PG8_MMA(1, 0, At, B0); PG8_BAR; PG8_SCHED;
            PG8_STAGE(PG8_SB(1, 1), b3 + hstepB, voffB);
            PG8_WAIT_V(6); PG8_BAR; PG8_MMA(1, 1, At, B1); PG8_BAR;
            }
        }
        if constexpr (ALIGN_EPI) { if (wr == 0) PG8_BAR; }
        if constexpr (!Epi::AFTER_DRAIN) { E(acc, cur, wr, wc, fr, fq); S.done(cur); }
        if (!has_next) break;
#pragma unroll
        for (int a = 0; a < 2; ++a)
#pragma unroll
            for (int b = 0; b < 2; ++b)
#pragma unroll
                for (int m = 0; m < 4; ++m)
#pragma unroll
                    for (int n = 0; n < 2; ++n) acc[a][b][m][n] = (f32x4){0.f, 0.f, 0.f, 0.f};
        cur = nxt; cA = nA; cB = nB; ++ui;
        if constexpr (ALIGN_EPI) { if (wr == 1) PG8_BAR; }
    }
    PG8_WAIT_V(0);
    if constexpr (!ALIGN_EPI) { if (wr == 0) PG8_BAR; }
    PG8_BAR;
    if constexpr (Epi::AFTER_DRAIN) { E.fused(acc, cur, wr, wc, fr, fq, lds, wid, lane); S.done(cur); }
#undef PG8_SA
#undef PG8_SB
#undef PG8_STAGE
#undef PG8_LDA
#undef PG8_LDB
#undef PG8_MMA
#undef PG8_WAIT_V
#undef PG8_WAIT_L
#undef PG8_BAR
#undef PG8_SCHED
}
}
#define LAS __attribute__((address_space(3)))
typedef unsigned short bf16;
typedef unsigned u32x4 __attribute__((ext_vector_type(4)));
typedef unsigned u32x2 __attribute__((ext_vector_type(2)));
typedef float f32x4 __attribute__((ext_vector_type(4)));
typedef float f32x16 __attribute__((ext_vector_type(16)));
typedef short bf16x8 __attribute__((ext_vector_type(8)));
constexpr int NT = 65536, DM = 1024, FF = 2816, SEQ = 2048, NBATCH = 32;
constexpr float RMS_EPS = 1e-6f;
constexpr size_t MiB = 1u << 20;
constexpr size_t WS_TAB = 0;
constexpr size_t WS_WIN = 1 * MiB;
constexpr size_t WS_WOUT = 45 * MiB;
constexpr size_t WS_WGLU = 67 * MiB, WS_WKV = 69 * MiB, WS_WQG = 72 * MiB, WS_WO = 75 * MiB;
constexpr size_t WS_CW1K = 77 * MiB, WS_CW1V = 77 * MiB + 512 * 1024, WS_CW2K = 78 * MiB, WS_CW2V = 78 * MiB + 65536;
constexpr size_t WS_KCMP = 80 * MiB, WS_VCMPT = 82 * MiB;
constexpr size_t WS_XN = 96 * MiB;
constexpr size_t WS_HB = WS_XN;
constexpr size_t WS_RP = 896 * MiB;
constexpr size_t WS_HID = 224 * MiB;
constexpr size_t WS_Q = WS_HID, WS_Z = WS_HID, WS_O = WS_HID + 128 * MiB, WS_GATES = WS_HID + 256 * MiB;
constexpr size_t WS_KV = 576 * MiB;
constexpr size_t WS_KN = 768 * MiB;
constexpr size_t WS_VT = 832 * MiB;
constexpr size_t WS_END = 920 * MiB;
constexpr int LDS_BYTES = 147456;
constexpr int MISC_OFF = 147328;
constexpr size_t WS_BAR = 65536;
constexpr int NPHASE = 14;

__device__ __forceinline__ unsigned f2bf(float f) { unsigned u = __builtin_bit_cast(unsigned, f); return (u + 0x7fffu + ((u >> 16) & 1u)) >> 16; }
typedef float f32x2_t __attribute__((ext_vector_type(2))); typedef __bf16 bf16x2_t __attribute__((ext_vector_type(2)));
__device__ __forceinline__ unsigned pk2(float lo, float hi) { f32x2_t v = {lo, hi}; bf16x2_t b = __builtin_convertvector(v, bf16x2_t); return __builtin_bit_cast(unsigned, b); }
__device__ __forceinline__ float bflo(unsigned w) { return __uint_as_float(w << 16); }
__device__ __forceinline__ float bfhi(unsigned w) { return __uint_as_float(w & 0xffff0000u); }
__device__ __forceinline__ float wave_sum(float v) {
#pragma unroll
    for (int o = 1; o < 64; o <<= 1) v += __shfl_xor(v, o);
    return v;
}
__device__ __forceinline__ float wave_max(float v) {
#pragma unroll
    for (int o = 1; o < 64; o <<= 1) v = fmaxf(v, __shfl_xor(v, o));
    return v;
}
#define LDS_WAIT() asm volatile("s_waitcnt lgkmcnt(0)" ::: "memory")
__device__ __forceinline__ float gelu_tanh(float y) { const float a = 1.5957691216057308f * (y + 0.044715f * y * y * y); return y * __builtin_amdgcn_rcpf(1.0f + __expf(-a)); }
__device__ __forceinline__ int crow(int r, int hi) { return (r & 3) + 8 * (r >> 2) + 4 * hi; }

struct Args { const float* in[32]; float* out; unsigned char* ws; int ph_lo, ph_hi; unsigned char seq[32]; };
typedef const __attribute__((address_space(4))) Args* KArgs;

__device__ __forceinline__ void tr_item(const float* W, int K, int ldn, int nvalid, int mode, bf16* WT, LAS float* scr, int item, int nblk, int lane, const float* gain) {
    const int kb = item / nblk, nb = item % nblk, k0 = 64 * kb, n0 = 64 * nb;
    int sc = n0;
    if (mode) { const int pn = n0 >> 8, rem = n0 & 255, bj = rem >> 7, i = rem & 127; sc = bj * 2816 + 128 * pn + i; }
    const int nq = lane & 15, kr = lane >> 4; const int c = sc + 4 * nq; const bool ok = c < nvalid;
    f32x4 v[16];
#pragma unroll
    for (int i = 0; i < 16; ++i) { const int kk = 4 * i + kr; v[i] = ok ? *(const f32x4*)(W + (size_t)(k0 + kk) * ldn + c) : (f32x4){0.f, 0.f, 0.f, 0.f}; }
#pragma unroll
    for (int i = 0; i < 16; ++i) { const int kk = 4 * i + kr; const float gk = gain ? gain[k0 + kk] : 1.0f; LAS float* d = scr + kk * 65 + 4 * nq;
        d[0] = v[i][0] * gk; d[1] = v[i][1] * gk; d[2] = v[i][2] * gk; d[3] = v[i][3] * gk; }
    LDS_WAIT();
    const int cc = lane & 7;
#pragma unroll
    for (int j = 0; j < 8; ++j) { const int n = (lane >> 3) + 8 * j; const LAS float* p = scr + (8 * cc) * 65 + n;
        u32x4 o; o.x = pk2(p[0 * 65], p[1 * 65]); o.y = pk2(p[2 * 65], p[3 * 65]); o.z = pk2(p[4 * 65], p[5 * 65]); o.w = pk2(p[6 * 65], p[7 * 65]);
        *(u32x4*)(WT + (size_t)(n0 + n) * K + k0 + 8 * cc) = o; }
    LDS_WAIT();
}
__device__ __forceinline__ void x_to_hb(const float* src, bf16* dst, float* rp, int gw, int NGW, int lane) {
    for (int m = gw; m < NT; m += NGW) {
        const f32x4* xr = (const f32x4*)(src + (size_t)m * DM) + lane;
        u32x2 w[4]; float s = 0.f;
#pragma unroll
        for (int j = 0; j < 4; ++j) { const f32x4 v = xr[64 * j]; w[j].x = pk2(v.x, v.y); w[j].y = pk2(v.z, v.w);
            const float q0 = bflo(w[j].x), q1 = bfhi(w[j].x), q2 = bflo(w[j].y), q3 = bfhi(w[j].y); s += (q0 * q0 + q1 * q1) + (q2 * q2 + q3 * q3); }
        s = wave_sum(s);
        u32x2* o8 = (u32x2*)(dst + (size_t)m * DM) + lane;
#pragma unroll
        for (int j = 0; j < 4; ++j) o8[64 * j] = w[j];
        if (lane == 0) *(f32x4*)(rp + (size_t)m * 4) = (f32x4){s, 0.f, 0.f, 0.f};
    }
}
__device__ __forceinline__ int t5_bucket(int d) {
    if (d < 16) return d;
    const float lv = __logf((float)d * (1.0f / 16.0f)) * (1.0f / 2.0794415416798357f);
    int b = 16 + (int)(lv * 16.0f); return b > 31 ? 31 : b;
}
__device__ __forceinline__ void p0_prologue(KArgs ap, LAS unsigned char* lds, int vcu, int G, int wave, int lane, int tid) {
    unsigned char* ws = ap->ws;
    LAS float* scr = (LAS float*)(lds + wave * 16640);
    const int gw = vcu * 8 + wave, NGW = G * 8;
    constexpr int I_IN = 16 * 88, I_OUT = 44 * 16, I_GLU = 16 * 16, I_KV = 16 * 24, I_QG = 16 * 20, I_O = 16 * 16, I_C1 = 32 * 2, I_C2 = 2 * 1;
    constexpr int NITEMS = 4 * I_IN + 4 * I_OUT + I_GLU + I_KV + I_QG + I_O + 2 * I_C1 + 2 * I_C2;
    for (int it = gw; it < NITEMS; it += NGW) {
        int r = it;
        if (r < 4 * I_IN) { const int f = r / I_IN; r -= f * I_IN; const int layer = f >> 1; const float* W = ((f & 1) ? ap->in[7] : ap->in[3]) + (size_t)layer * 1024 * 5632;
            tr_item(W, 1024, 5632, 5632, 1, (bf16*)(ws + WS_WIN + (size_t)f * 11 * MiB), scr, r, 88, lane, ((f & 1) ? ap->in[6] : ap->in[2]) + layer * 1024); continue; } r -= 4 * I_IN;
        if (r < 4 * I_OUT) { const int f = r / I_OUT; r -= f * I_OUT; const int layer = f >> 1; const float* W = ((f & 1) ? ap->in[8] : ap->in[4]) + (size_t)layer * 2816 * 1024;
            tr_item(W, 2816, 1024, 1024, 0, (bf16*)(ws + WS_WOUT + (size_t)f * (11 * MiB / 2)), scr, r, 16, lane, nullptr); continue; } r -= 4 * I_OUT;
        if (r < I_GLU) { tr_item(ap->in[17], 1024, 1024, 1024, 0, (bf16*)(ws + WS_WGLU), scr, r, 16, lane, nullptr); continue; } r -= I_GLU;
        if (r < I_KV) { tr_item(ap->in[19], 1024, 1536, 1536, 0, (bf16*)(ws + WS_WKV), scr, r, 24, lane, ap->in[18]); continue; } r -= I_KV;
        if (r < I_QG) { tr_item(ap->in[29], 1024, 1072, 1072, 0, (bf16*)(ws + WS_WQG), scr, r, 20, lane, ap->in[5] + 1024); continue; } r -= I_QG;
        if (r < I_O) { tr_item(ap->in[31], 1024, 1024, 1024, 0, (bf16*)(ws + WS_WO), scr, r, 16, lane, nullptr); continue; } r -= I_O;
        if (r < I_C1) { tr_item(ap->in[25], 2048, 128, 128, 0, (bf16*)(ws + WS_CW1K), scr, r, 2, lane, nullptr); continue; } r -= I_C1;
        if (r < I_C1) { tr_item(ap->in[27], 2048, 128, 128, 0, (bf16*)(ws + WS_CW1V), scr, r, 2, lane, nullptr); continue; } r -= I_C1;
        if (r < I_C2) { tr_item(ap->in[26], 128, 64, 64, 0, (bf16*)(ws + WS_CW2K), scr, r, 1, lane, nullptr); continue; } r -= I_C2;
        tr_item(ap->in[28], 128, 64, 64, 0, (bf16*)(ws + WS_CW2V), scr, r, 1, lane, nullptr);
    }
    float* tab = (float*)(ws + WS_TAB);
    if (vcu == G - 1) {
        for (int idx = tid; idx < 2048; idx += 512) { const int h = idx >> 7, d = idx & 127; tab[idx] = ap->in[1][t5_bucket(d) * 16 + h]; }
        if (wave == 0) {
            const float mq = wave_max(fabsf(ap->in[30][lane]));
            float mb = 0.f; for (int i = lane; i < 512; i += 64) mb = fmaxf(mb, fabsf(ap->in[1][i])); mb = wave_max(mb);
            const float mc = wave_max(fabsf(ap->in[20][lane])), ms = wave_max(fabsf(ap->in[21][lane])), mw = wave_max(fabsf(ap->in[22][lane]));
            if (lane == 0) { tab[2048] = 8.f * mq * mc + mb; tab[2049] = 8.f * mq * ms + mb; tab[2050] = 8.f * mq * mw + mb; tab[2051] = 0.f; }
        }
    }
    x_to_hb(ap->in[0], (bf16*)(ws + WS_HB), (float*)(ws + WS_RP), gw, NGW, lane);
}
constexpr int S5_KTAB = 0, S5_ABP = 8192, S5_BBC = 16384, S5_UT = 24576, S5_XS = 59392;
__device__ __forceinline__ void s5_phase(KArgs ap, LAS unsigned char* lds, int vcu, int G, int wave, int lane, int tid) {
    unsigned char* ws = ap->ws;
    const bf16* HBp = (const bf16*)(ws + WS_HB); bf16* Z = (bf16*)(ws + WS_Z); const float* rp1 = (const float*)(ws + WS_RP + 1 * 4 * MiB);
    LAS float* KTAB = (LAS float*)(lds + S5_KTAB); LAS float* ABP = (LAS float*)(lds + S5_ABP); LAS float* BBC = (LAS float*)(lds + S5_BBC); LAS float* CC = (LAS float*)(lds + 68096);
    const int fr = lane & 15, fq = lane >> 4;
    for (int item = vcu; item < 128; item += G) {
        const int g = item >> 1, b0 = (item & 1) * 16;
        __syncthreads();
        {
            const int p = tid & 63, part = tid >> 6;
            const float dt = expf(ap->in[11][g]);
            const float are = ap->in[9][g * 64 + p], aim = ap->in[10][g * 64 + p];
            const float mag = expf(are * dt); const float abr = mag * __cosf(aim * dt), abi = mag * __sinf(aim * dt);
            if (part == 0) { float pr = 1.f, pi = 0.f;
                for (int t = 0; t <= 8; ++t) { ABP[(t * 64 + p) * 2] = pr; ABP[(t * 64 + p) * 2 + 1] = pi; const float nr = pr * abr - pi * abi, ni = pr * abi + pi * abr; pr = nr; pi = ni; } }
            const float den = are * are + aim * aim;
            const float zr = ((abr - 1.0f) * are + abi * aim) / den, zi = (abi * are - (abr - 1.0f) * aim) / den;
#pragma unroll
            for (int e = 0; e < 2; ++e) { const int h = 2 * part + e; const float br = ap->in[12][(size_t)(g * 64 + p) * 16 + h], bi = ap->in[13][(size_t)(g * 64 + p) * 16 + h]; const float gn = ap->in[5][g * 16 + h];
                BBC[(p * 16 + h) * 2] = (zr * br - zi * bi) * gn; BBC[(p * 16 + h) * 2 + 1] = (zr * bi + zi * br) * gn; }
            for (int i = tid; i < 1024; i += 512) { CC[2 * i] = ap->in[14][(size_t)g * 1024 + i]; CC[2 * i + 1] = ap->in[15][(size_t)g * 1024 + i]; }
        }
        __syncthreads();
        {
            const int hp = tid & 15, h = (tid >> 4) & 15, tau0 = (tid >> 8) * 4;
            float acc[4] = {0.f, 0.f, 0.f, 0.f};
            for (int p = 0; p < 64; ++p) {
                const float cr = CC[(hp * 64 + p) * 2], ci = CC[(hp * 64 + p) * 2 + 1], br = BBC[(p * 16 + h) * 2], bi = BBC[(p * 16 + h) * 2 + 1];
                const float wr = cr * br - ci * bi, wi = cr * bi + ci * br;
#pragma unroll
                for (int e = 0; e < 4; ++e) { const float ar = ABP[((tau0 + e) * 64 + p) * 2], ai = ABP[((tau0 + e) * 64 + p) * 2 + 1]; acc[e] += wr * ar - wi * ai; }
            }
            if (tau0 == 0 && h == hp) acc[0] += ap->in[16][g * 16 + h] * ap->in[5][g * 16 + h];
#pragma unroll
            for (int e = 0; e < 4; ++e) KTAB[(tau0 + e) * 256 + h * 16 + hp] = acc[e];
        }
        __syncthreads();
        bf16x8 BY[4], BC[4], BX[4];
        const int t = wave;
#pragma unroll
        for (int ks = 0; ks < 4; ++ks) { const int sx = 2 * ks + (fq >> 1); float v[8];
#pragma unroll
            for (int j = 0; j < 8; ++j) { const int h = (fq & 1) * 8 + j; v[j] = (t >= sx) ? KTAB[((t - sx) * 16 + h) * 16 + fr] : 0.f; }
            u32x4 w; w.x = pk2(v[0], v[1]); w.y = pk2(v[2], v[3]); w.z = pk2(v[4], v[5]); w.w = pk2(v[6], v[7]); BY[ks] = __builtin_bit_cast(bf16x8, w); }
#pragma unroll
        for (int ks = 0; ks < 4; ++ks) { float v[8];
#pragma unroll
            for (int jj = 0; jj < 4; ++jj) { const int p = 16 * ks + 4 * fq + jj; const float cr = CC[(fr * 64 + p) * 2], ci = CC[(fr * 64 + p) * 2 + 1];
                const float ar = ABP[((t + 1) * 64 + p) * 2], ai = ABP[((t + 1) * 64 + p) * 2 + 1]; v[2 * jj] = cr * ar - ci * ai; v[2 * jj + 1] = -(cr * ai + ci * ar); }
            u32x4 w; w.x = pk2(v[0], v[1]); w.y = pk2(v[2], v[3]); w.z = pk2(v[4], v[5]); w.w = pk2(v[6], v[7]); BC[ks] = __builtin_bit_cast(bf16x8, w); }
        const int cidx = 16 * wave + fr, xp = cidx >> 1, xcomp = cidx & 1;
#pragma unroll
        for (int ks = 0; ks < 4; ++ks) { const int sx = 2 * ks + (fq >> 1); float v[8];
            const float ar = ABP[((7 - sx) * 64 + xp) * 2], ai = ABP[((7 - sx) * 64 + xp) * 2 + 1];
#pragma unroll
            for (int j = 0; j < 8; ++j) { const int h = (fq & 1) * 8 + j; const float br = BBC[(xp * 16 + h) * 2], bi = BBC[(xp * 16 + h) * 2 + 1]; v[j] = xcomp ? (ar * bi + ai * br) : (ar * br - ai * bi); }
            u32x4 w; w.x = pk2(v[0], v[1]); w.y = pk2(v[2], v[3]); w.z = pk2(v[4], v[5]); w.w = pk2(v[6], v[7]); BX[ks] = __builtin_bit_cast(bf16x8, w); }
        const float a8r = ABP[(8 * 64 + xp) * 2], a8i = ABP[(8 * 64 + xp) * 2 + 1] * (xcomp ? 1.f : -1.f);
        LAS unsigned char* UT = lds + S5_UT; LAS unsigned char* XS = lds + S5_XS;
        for (int i = tid; i < 16 * 136 / 2; i += 512) ((LAS unsigned*)XS)[i] = 0u;
        f32x4 rot = {0.f, 0.f, 0.f, 0.f};
        const bf16* up[2]; const float* rpp[2]; int uoff[2];
#pragma unroll
        for (int e = 0; e < 2; ++e) { const int q = tid + 512 * e, tl = q >> 8, sbb = (q >> 4) & 15, stk = (q & 15) >> 1, h8 = q & 1;
            up[e] = HBp + (size_t)((b0 + sbb) * SEQ + tl * 8 + stk) * DM + g * 16 + h8 * 8; rpp[e] = rp1 + (size_t)((b0 + sbb) * SEQ + tl * 8 + stk) * 4;
            uoff[e] = tl * 4352 + sbb * 272 + (stk * 16 + h8 * 8) * 2; }
        u32x4 pre[2]; f32x4 prs4[2];
#pragma unroll
        for (int e = 0; e < 2; ++e) { pre[e] = *(const u32x4*)up[e]; prs4[e] = *(const f32x4*)rpp[e]; }
        for (int st = 0; st < 64; ++st) {
            LAS unsigned char* UTs = UT + (st & 1) * 17408;
#pragma unroll
            for (int e = 0; e < 2; ++e) { const float rs = __builtin_amdgcn_rsqf(((prs4[e][0] + prs4[e][1]) + (prs4[e][2] + prs4[e][3])) * (1.0f / 1024.0f) + RMS_EPS);
                u32x4 w; w.x = pk2(bflo(pre[e].x) * rs, bfhi(pre[e].x) * rs); w.y = pk2(bflo(pre[e].y) * rs, bfhi(pre[e].y) * rs); w.z = pk2(bflo(pre[e].z) * rs, bfhi(pre[e].z) * rs); w.w = pk2(bflo(pre[e].w) * rs, bfhi(pre[e].w) * rs);
                *(LAS u32x4*)(UTs + uoff[e]) = w; }
#pragma unroll 1
            for (int tl = 0; tl < 4; ++tl) {
                const int tile = st * 4 + tl, buf = tile & 1;
                asm volatile("s_waitcnt lgkmcnt(0)" ::: "memory"); __builtin_amdgcn_s_barrier(); asm volatile("" ::: "memory");
                if (tl == 0 && st + 1 < 64) {
#pragma unroll
                    for (int e = 0; e < 2; ++e) { pre[e] = *(const u32x4*)(up[e] + (size_t)(st + 1) * 32 * DM); prs4[e] = *(const f32x4*)(rpp[e] + (size_t)(st + 1) * 32 * 4); } }
                bf16x8 au[4];
#pragma unroll
                for (int ks = 0; ks < 4; ++ks) au[ks] = *(const LAS bf16x8*)(UTs + tl * 4352 + fr * 272 + (32 * ks + 8 * fq) * 2);
                f32x4 nxa = rot, nxb = {0.f, 0.f, 0.f, 0.f};
                nxa = __builtin_amdgcn_mfma_f32_16x16x32_bf16(au[0], BX[0], nxa, 0, 0, 0);
                nxb = __builtin_amdgcn_mfma_f32_16x16x32_bf16(au[2], BX[2], nxb, 0, 0, 0);
                nxa = __builtin_amdgcn_mfma_f32_16x16x32_bf16(au[1], BX[1], nxa, 0, 0, 0);
                nxb = __builtin_amdgcn_mfma_f32_16x16x32_bf16(au[3], BX[3], nxb, 0, 0, 0);
                const f32x4 nx = nxa + nxb;
#pragma unroll
                for (int j = 0; j < 4; ++j) *(LAS bf16*)(XS + (buf ^ 1) * 4352 + (4 * fq + j) * 272 + cidx * 2) = (bf16)(pk2(nx[j], 0.f) & 0xffffu);
                __builtin_amdgcn_sched_barrier(0);
                { const f32x4 oth = {__shfl_xor(nx[0], 1), __shfl_xor(nx[1], 1), __shfl_xor(nx[2], 1), __shfl_xor(nx[3], 1)};
                  rot = nx * a8r + oth * a8i; }
                f32x4 acc0 = {0.f, 0.f, 0.f, 0.f}, acc1 = {0.f, 0.f, 0.f, 0.f};
#pragma unroll
                for (int ks = 0; ks < 4; ++ks) acc0 = __builtin_amdgcn_mfma_f32_16x16x32_bf16(au[ks], BY[ks], acc0, 0, 0, 0);
#pragma unroll
                for (int ks = 0; ks < 4; ++ks) { const bf16x8 a = *(const LAS bf16x8*)(XS + buf * 4352 + fr * 272 + (32 * ks + 8 * fq) * 2);
                    acc1 = __builtin_amdgcn_mfma_f32_16x16x32_bf16(a, BC[ks], acc1, 0, 0, 0); }
                const int tok = tile * 8 + wave;
#pragma unroll
                for (int j = 0; j < 4; ++j) Z[(size_t)((b0 + 4 * fq + j) * SEQ + tok) * DM + g * 16 + fr] = (bf16)(pk2(gelu_tanh(acc0[j] + acc1[j]), 0.f) & 0xffffu);
            }
        }
    }
}

__device__ __forceinline__ void kvpost_phase(KArgs ap, LAS unsigned char* lds, int gw, int NGW, int wave, int lane) {
    unsigned char* ws = ap->ws;
    const bf16* KV = (const bf16*)(ws + WS_KV); bf16* KN = (bf16*)(ws + WS_KN); bf16* VT = (bf16*)(ws + WS_VT);
    LAS bf16* Vs = (LAS bf16*)(lds + wave * 8704);
    const int ch = lane & 7, tr = lane >> 3;
    for (int item = gw; item < 8192; item += NGW) {
        const int tt = item & 31, g = (item >> 5) & 3, b = (item >> 7) & 31, which = item >> 12;
        const float* gain = which ? ap->in[22] : ap->in[21];
        const f32x4 g0 = *(const f32x4*)(gain + ch * 8), g1 = *(const f32x4*)(gain + ch * 8 + 4);
        const bf16* src = KV + ((size_t)((2 + 2 * which) * 4 + g) * NT + b * SEQ + tt * 64) * 64;
        bf16* kdst = KN + ((size_t)((which * 32 + b) * 4 + g) * SEQ + tt * 64) * 64;
        bf16* vdst = VT + (size_t)((which * 32 + b) * 4 + g) * 64 * SEQ + tt * 64;
#pragma unroll
        for (int i = 0; i < 8; ++i) {
            const int tok = i * 8 + tr;
            const u32x4 kr = *(const u32x4*)(src + (size_t)tok * 64 + ch * 8);
            const u32x4 vr = *(const u32x4*)(src + (size_t)4 * NT * 64 + (size_t)tok * 64 + ch * 8);
            float x[8] = {bflo(kr.x), bfhi(kr.x), bflo(kr.y), bfhi(kr.y), bflo(kr.z), bfhi(kr.z), bflo(kr.w), bfhi(kr.w)};
            float ss = 0.f;
#pragma unroll
            for (int e = 0; e < 8; ++e) ss += x[e] * x[e];
            ss += __shfl_xor(ss, 1); ss += __shfl_xor(ss, 2); ss += __shfl_xor(ss, 4);
            const float rs = rsqrtf(ss * (1.f / 64.f) + RMS_EPS);
            u32x4 o; o.x = pk2(x[0] * rs * g0[0], x[1] * rs * g0[1]); o.y = pk2(x[2] * rs * g0[2], x[3] * rs * g0[3]); o.z = pk2(x[4] * rs * g1[0], x[5] * rs * g1[1]); o.w = pk2(x[6] * rs * g1[2], x[7] * rs * g1[3]);
            *(u32x4*)(kdst + (size_t)tok * 64 + ch * 8) = o;
            LAS unsigned* vw = (LAS unsigned*)(Vs + tok * 66 + ch * 8); vw[0] = vr.x; vw[1] = vr.y; vw[2] = vr.z; vw[3] = vr.w;
        }
        LDS_WAIT();
#pragma unroll
        for (int i = 0; i < 8; ++i) {
            const int d = i * 8 + tr;
            unsigned e[8];
#pragma unroll
            for (int q = 0; q < 8; ++q) e[q] = Vs[(ch * 8 + q) * 66 + d];
            u32x4 o; o.x = e[0] | (e[1] << 16); o.y = e[2] | (e[3] << 16); o.z = e[4] | (e[5] << 16); o.w = e[6] | (e[7] << 16);
            *(u32x4*)(vdst + (size_t)d * SEQ + ch * 8) = o;
        }
        LDS_WAIT();
    }
}

__device__ __forceinline__ void compress_phase(KArgs ap, LAS unsigned char* lds, int vcu, int G, int wave, int lane) {
    unsigned char* ws = ap->ws;
    const bf16* KV = (const bf16*)(ws + WS_KV);
    const float* tab = (const float*)(ws + WS_TAB);
    const int fr = lane & 15, fq = lane >> 4;
    LAS bf16* Hs = (LAS bf16*)(lds + 73728 + wave * 4352);
    for (int unit = vcu; unit < 256; unit += G) {
        const int kv = unit >> 7, b = (unit >> 2) & 31, g = unit & 3;
        const bf16* W1 = (const bf16*)(ws + (kv ? WS_CW1V : WS_CW1K)); const bf16* W2 = (const bf16*)(ws + (kv ? WS_CW2V : WS_CW2K));
        const int c0 = wave * 16;
        const float* posp = kv ? ap->in[24] : ap->in[23];
        const bf16* abase = KV + ((size_t)(kv * 4 + g) * NT + b * SEQ) * 64 + fq * 8;
        const int tokb = 16 * (c0 + fr);
        f32x4 acc[8];
#pragma unroll
        for (int n = 0; n < 8; ++n) acc[n] = (f32x4){0.f, 0.f, 0.f, 0.f};
#define CMP_LOAD(AR, P0, P1, BV, KS) do { int tok_ = tokb + ((KS) >> 1); tok_ = tok_ > SEQ - 1 ? SEQ - 1 : tok_; \
            AR = *(const u32x4*)(abase + (size_t)tok_ * 64 + ((KS) & 1) * 32); \
            const float* pp_ = posp + ((KS) >> 1) * 64 + ((KS) & 1) * 32 + fq * 8; P0 = *(const f32x4*)pp_; P1 = *(const f32x4*)(pp_ + 4); \
            _Pragma("unroll") for (int n = 0; n < 8; ++n) BV[n] = *(const bf16x8*)(W1 + (size_t)(n * 16 + fr) * 2048 + (KS) * 32 + fq * 8); } while (0)
#define CMP_MMA(AR, P0, P1, BV) do { u32x4 aw_; aw_.x = pk2(bflo(AR.x) + P0[0], bfhi(AR.x) + P0[1]); aw_.y = pk2(bflo(AR.y) + P0[2], bfhi(AR.y) + P0[3]); \
            aw_.z = pk2(bflo(AR.z) + P1[0], bfhi(AR.z) + P1[1]); aw_.w = pk2(bflo(AR.w) + P1[2], bfhi(AR.w) + P1[3]); const bf16x8 av_ = __builtin_bit_cast(bf16x8, aw_); \
            _Pragma("unroll") for (int n = 0; n < 8; ++n) acc[n] = __builtin_amdgcn_mfma_f32_16x16x32_bf16(av_, BV[n], acc[n], 0, 0, 0); } while (0)
        {
            u32x4 arA, arB; f32x4 pA0, pA1, pB0, pB1; bf16x8 bvA[8], bvB[8];
            CMP_LOAD(arA, pA0, pA1, bvA, 0);
#pragma unroll 1
            for (int ks = 0; ks < 64; ks += 2) {
                CMP_LOAD(arB, pB0, pB1, bvB, ks + 1);
                __builtin_amdgcn_sched_barrier(0);
                CMP_MMA(arA, pA0, pA1, bvA);
                __builtin_amdgcn_sched_barrier(0);
                if (ks + 2 < 64) CMP_LOAD(arA, pA0, pA1, bvA, ks + 2);
                __builtin_amdgcn_sched_barrier(0);
                CMP_MMA(arB, pB0, pB1, bvB);
                __builtin_amdgcn_sched_barrier(0);
            }
        }
#undef CMP_LOAD
#undef CMP_MMA
#pragma unroll
        for (int n = 0; n < 8; ++n) { const float pb = 0.f;
#pragma unroll
            for (int j = 0; j < 4; ++j) Hs[(4 * fq + j) * 136 + n * 16 + fr] = (bf16)f2bf(gelu_tanh(acc[n][j] + pb)); }
        LDS_WAIT();
        bf16x8 ha[4];
#pragma unroll
        for (int ks = 0; ks < 4; ++ks) ha[ks] = *(const LAS bf16x8*)(Hs + fr * 136 + 32 * ks + 8 * fq);
        f32x4 o2[4];
#pragma unroll
        for (int n = 0; n < 4; ++n) { o2[n] = (f32x4){0.f, 0.f, 0.f, 0.f};
#pragma unroll
            for (int ks = 0; ks < 4; ++ks) { const bf16x8 bv = *(const bf16x8*)(W2 + (size_t)(n * 16 + fr) * 128 + ks * 32 + fq * 8); o2[n] = __builtin_amdgcn_mfma_f32_16x16x32_bf16(ha[ks], bv, o2[n], 0, 0, 0); } }
        LDS_WAIT();
        if (kv == 0) {
            bf16* dst = (bf16*)(ws + WS_KCMP) + (size_t)((b * 4 + g) * 128) * 64;
#pragma unroll
            for (int j = 0; j < 4; ++j) { float ss = 0.f;
#pragma unroll
                for (int n = 0; n < 4; ++n) ss += o2[n][j] * o2[n][j];
                ss += __shfl_xor(ss, 1); ss += __shfl_xor(ss, 2); ss += __shfl_xor(ss, 4); ss += __shfl_xor(ss, 8);
                const float rs = rsqrtf(ss * (1.f / 64.f) + RMS_EPS); const int c = c0 + 4 * fq + j;
#pragma unroll
                for (int n = 0; n < 4; ++n) { const float v = (c < 127) ? o2[n][j] * rs * ap->in[20][n * 16 + fr] : 0.f; dst[(size_t)c * 64 + n * 16 + fr] = (bf16)f2bf(v); } }
        } else {
            bf16* dst = (bf16*)(ws + WS_VCMPT) + (size_t)((b * 4 + g) * 64) * 128;
#pragma unroll
            for (int n = 0; n < 4; ++n) { const int c = c0 + 4 * fq; float v[4];
#pragma unroll
                for (int j = 0; j < 4; ++j) v[j] = (c + j < 127) ? o2[n][j] : 0.f;
                u32x2 w; w.x = pk2(v[0], v[1]); w.y = pk2(v[2], v[3]); *(u32x2*)(dst + (size_t)(n * 16 + fr) * 128 + c) = w; }
        }
    }
}
constexpr int AT_KT = 0, AT_VT = 36864, AT_PSL = 0, AT_BIAS = 71680, AT_SEL = 73728, AT_TOT = 73984, AT_STRIDE = 144;
constexpr float LOG2E = 1.4426950408889634f;
#define MFMA32(a, b, c) __builtin_amdgcn_mfma_f32_32x32x16_bf16((a), (b), (c), 0, 0, 0)
__device__ __forceinline__ bf16x8 pack8(const f32x16& s, int s2) {
    u32x4 w; w.x = pk2(s[8 * s2 + 0], s[8 * s2 + 1]); w.y = pk2(s[8 * s2 + 2], s[8 * s2 + 3]); w.z = pk2(s[8 * s2 + 4], s[8 * s2 + 5]); w.w = pk2(s[8 * s2 + 6], s[8 * s2 + 7]);
    return __builtin_bit_cast(bf16x8, w);
}
template <int MODE>
__device__ __forceinline__ void attn_first_load(const bf16* Kg, const bf16* Vg, int qt, int tid, u32x4 (&kreg)[2], u32x4 (&vreg)[2]) {
    const int kb_lo = MODE == 0 ? 0 : (qt > 8 ? qt - 8 : 0), kb_hi = qt;
    const int kb0 = kb_lo - ((kb_hi - kb_lo + 1) & 1);
    const int krow = tid >> 2, kch = tid & 3, vrow = tid >> 3, vch = tid & 7;
    const bf16* kp = Kg + (size_t)(krow & 63) * 64 + kch * 16; const int ksub = krow >> 6;
    const bf16* vp = Vg + (size_t)vrow * SEQ + (vch & 3) * 16; const int vsub = vch >> 2;
    const int kbk = (kb0 + ksub) < kb_lo ? kb_lo : (kb0 + ksub), kbv = (kb0 + vsub) < kb_lo ? kb_lo : (kb0 + vsub);
    kreg[0] = *(const u32x4*)(kp + (size_t)kbk * 4096); kreg[1] = *(const u32x4*)(kp + (size_t)kbk * 4096 + 8);
    vreg[0] = *(const u32x4*)(vp + kbv * 64); vreg[1] = *(const u32x4*)(vp + kbv * 64 + 8);
}
template <int MODE>
__device__ __forceinline__ void attn_loop(LAS unsigned char* lds, const bf16* Kg, const bf16* Vg, int qt, int tq, unsigned selm, const bf16x8 (&qf)[4], const LAS float* biasr, float nshift,
                                          f32x16 (&o)[2], float& lsum, int tid, int ql, int hi, u32x4 (&kreg)[2], u32x4 (&vreg)[2]) {
    const int kb_lo = MODE == 0 ? 0 : (qt > 8 ? qt - 8 : 0), kb_hi = qt;
    const int kb0 = kb_lo - ((kb_hi - kb_lo + 1) & 1);
    const int krow = tid >> 2, kch = tid & 3, vrow = tid >> 3, vch = tid & 7;
    const bf16* kp = Kg + (size_t)(krow & 63) * 64 + kch * 16; const int ksub = krow >> 6;
    const bf16* vp = Vg + (size_t)vrow * SEQ + (vch & 3) * 16; const int vsub = vch >> 2;
#pragma unroll
    for (int i = 0; i < 16; ++i) { o[0][i] = 0.f; o[1][i] = 0.f; }
    float l = 0.f;
    const float bfar = biasr[127];
    int it = 0;
    for (int kb = kb0; kb < kb_hi; kb += 2, ++it) {
        const int buf = it & 1;
        LAS unsigned char* KT = lds + AT_KT + buf * 18432; LAS unsigned char* VT = lds + AT_VT + buf * 17408;
        *(LAS u32x4*)(KT + krow * AT_STRIDE + kch * 32) = kreg[0]; *(LAS u32x4*)(KT + krow * AT_STRIDE + kch * 32 + 16) = kreg[1];
        *(LAS u32x4*)(VT + vrow * 272 + vch * 32) = vreg[0]; *(LAS u32x4*)(VT + vrow * 272 + vch * 32 + 16) = vreg[1];
        __syncthreads();
        if (kb + 2 < kb_hi) { const int kbk = kb + 2 + ksub, kbv = kb + 2 + vsub;
            kreg[0] = *(const u32x4*)(kp + (size_t)kbk * 4096); kreg[1] = *(const u32x4*)(kp + (size_t)kbk * 4096 + 8);
            vreg[0] = *(const u32x4*)(vp + kbv * 64); vreg[1] = *(const u32x4*)(vp + kbv * 64 + 8); }
#pragma unroll
        for (int sb = 0; sb < 2; ++sb) {
            const int kbb = kb + sb;
            if (kbb < kb_lo) continue;
            f32x16 s[2];
            bf16x8 kf[8];
#pragma unroll
            for (int kt = 0; kt < 2; ++kt)
#pragma unroll
                for (int ks = 0; ks < 4; ++ks) kf[kt * 4 + ks] = *(const LAS bf16x8*)(KT + (64 * sb + 32 * kt + ql) * AT_STRIDE + (16 * ks + 8 * hi) * 2);
            const bool bsel = (kbb >= kb_lo) && (MODE == 1 || ((selm >> (kbb & 31)) & 1u) != 0u);
            const int delta = qt - kbb;
            const bool interior = delta >= 3 && (MODE == 0 || delta <= 7);
            const bool edge = MODE == 1 && delta >= 3 && !interior;
            const float sinit = interior ? (nshift + (bsel ? bfar : -INFINITY)) : (edge ? nshift + bfar : nshift);
            __builtin_amdgcn_sched_barrier(0);
#pragma unroll
            for (int kt = 0; kt < 2; ++kt)
#pragma unroll
                for (int i = 0; i < 16; ++i) s[kt][i] = sinit;
            __builtin_amdgcn_s_setprio(1);
#pragma unroll
            for (int kt = 0; kt < 2; ++kt)
#pragma unroll
                for (int ks = 0; ks < 4; ++ks) s[kt] = MFMA32(kf[kt * 4 + ks], qf[ks], s[kt]);
            __builtin_amdgcn_s_setprio(0);
            if (interior) {
#pragma unroll
                for (int kt = 0; kt < 2; ++kt)
#pragma unroll
                    for (int i = 0; i < 16; ++i) { const float pv = __builtin_amdgcn_exp2f(s[kt][i]); s[kt][i] = pv; l += pv; }
            } else if (edge) {
                const int D0 = tq - kbb * 64 - 4 * hi;
#pragma unroll
                for (int kt = 0; kt < 2; ++kt)
#pragma unroll
                    for (int i = 0; i < 16; ++i) {
                        const int dist = D0 - (32 * kt + (i & 3) + 8 * (i >> 2));
                        const float pv = dist < 512 ? __builtin_amdgcn_exp2f(s[kt][i]) : 0.f;
                        s[kt][i] = pv; l += pv;
                    }
            } else {
                const int D0 = tq - kbb * 64 - 4 * hi;
#pragma unroll
                for (int kt = 0; kt < 2; ++kt)
#pragma unroll
                    for (int i = 0; i < 16; ++i) {
                        const int dist = D0 - (32 * kt + (i & 3) + 8 * (i >> 2));
                        bool valid = bsel && dist >= 0; if (MODE == 1) valid = valid && dist < 512;
                        const int di = dist < 0 ? 0 : (dist > 127 ? 127 : dist);
                        const float pv = valid ? __builtin_amdgcn_exp2f(s[kt][i] + biasr[di]) : 0.f;
                        s[kt][i] = pv; l += pv;
                    }
            }
#pragma unroll
            for (int kt = 0; kt < 2; ++kt) {
                u32x2 vlo[4], vhi[4];
#pragma unroll
                for (int s2 = 0; s2 < 2; ++s2)
#pragma unroll
                    for (int mt = 0; mt < 2; ++mt) { const LAS unsigned char* vb = VT + (32 * mt + ql) * 272 + (64 * sb + 32 * kt + 16 * s2 + 4 * hi) * 2;
                        vlo[s2 * 2 + mt] = *(const LAS u32x2*)vb; vhi[s2 * 2 + mt] = *(const LAS u32x2*)(vb + 16); }
                const bf16x8 pb0 = pack8(s[kt], 0), pb1 = pack8(s[kt], 1);
                __builtin_amdgcn_sched_barrier(0);
                __builtin_amdgcn_s_setprio(1);
#pragma unroll
                for (int s2 = 0; s2 < 2; ++s2)
#pragma unroll
                    for (int mt = 0; mt < 2; ++mt) {
                        const u32x2 lo = vlo[s2 * 2 + mt], hi2 = vhi[s2 * 2 + mt];
                        u32x4 w; w.x = lo.x; w.y = lo.y; w.z = hi2.x; w.w = hi2.y;
                        o[mt] = MFMA32(__builtin_bit_cast(bf16x8, w), s2 ? pb1 : pb0, o[mt]);
                    }
                __builtin_amdgcn_s_setprio(0);
            }
        }
    }
    l += __shfl_xor(l, 32);
    lsum = l;
    __syncthreads();
}

__device__ __forceinline__ void attn_phase(KArgs ap, LAS unsigned char* lds, int vcu, int G, int wave, int lane, int tid) {
    const int r = wave >> 1, th = wave & 1, ql = lane & 31, hi = lane >> 5;
    LAS float* PSL = (LAS float*)(lds + AT_PSL); LAS float* BIAS = (LAS float*)(lds + AT_BIAS); LAS unsigned* SEL = (LAS unsigned*)(lds + AT_SEL);
#define ATT_QLOAD(U) do { const int bg_ = ((U) & 255) >> 1, par_ = (U) & 1, ii_ = (U) >> 8, k2_ = ii_ >> 1; const int qt_ = (ii_ & 1) ? (31 - 2 * k2_ - par_) : (2 * k2_ + par_); \
        const int b_ = bg_ >> 2, h_ = (bg_ & 3) * 4 + r; const size_t row_ = (size_t)(b_ * SEQ + qt_ * 64 + th * 32 + ql); \
        const bf16* qp_ = (const bf16*)(ap->ws + WS_Q) + row_ * DM + h_ * 64 + 8 * hi; \
        _Pragma("unroll") for (int ks = 0; ks < 4; ++ks) qraw[ks] = *(const u32x4*)(qp_ + 16 * ks); \
        const float* gp_ = (const float*)(ap->ws + WS_GATES) + row_ * 48 + h_ * 3; gtn0 = gp_[0]; gtn1 = gp_[1]; gtn2 = gp_[2]; } while (0)
    u32x4 qraw[4]; float gtn0 = 0.f, gtn1 = 0.f, gtn2 = 0.f;
    if (vcu < 4096) ATT_QLOAD(vcu);
    for (int u = vcu; u < 4096; u += G) {
        asm volatile("" : "+s"(ap));
        unsigned char* ws = ap->ws;
        const float* tab = (const float*)(ws + WS_TAB);
        const bf16* Qb = (const bf16*)(ws + WS_Q); const float* gatesb = (const float*)(ws + WS_GATES); bf16* Ob = (bf16*)(ws + WS_O);
        const bf16* KN = (const bf16*)(ws + WS_KN); const bf16* VTg = (const bf16*)(ws + WS_VT);
        const bf16* KC = (const bf16*)(ws + WS_KCMP); const bf16* VC = (const bf16*)(ws + WS_VCMPT);
        const float sh_cmp = -tab[2048] * LOG2E, sh_slc = -tab[2049] * LOG2E, sh_win = -tab[2050] * LOG2E;
        const int bg = (u & 255) >> 1, par = u & 1, ii = u >> 8, k2 = ii >> 1;
        const int qt = (ii & 1) ? (31 - 2 * k2 - par) : (2 * k2 + par);
        const int b = bg >> 2, g = bg & 3, h = g * 4 + r;
        const int tq = qt * 64 + th * 32 + ql;
        BIAS[tid] = tab[g * 512 + tid] * LOG2E;
        bf16x8 qf[4];
        {
            u32x4 raw[4]; float ss = 0.f;
#pragma unroll
            for (int ks = 0; ks < 4; ++ks) { raw[ks] = qraw[ks];
                const float x0 = bflo(raw[ks].x), x1 = bfhi(raw[ks].x), x2 = bflo(raw[ks].y), x3 = bfhi(raw[ks].y), x4 = bflo(raw[ks].z), x5 = bfhi(raw[ks].z), x6 = bflo(raw[ks].w), x7 = bfhi(raw[ks].w);
                ss += (x0 * x0 + x1 * x1) + (x2 * x2 + x3 * x3) + (x4 * x4 + x5 * x5) + (x6 * x6 + x7 * x7); }
            ss += __shfl_xor(ss, 32);
            const float rs = rsqrtf(ss * (1.f / 64.f) + RMS_EPS) * (0.125f * LOG2E);
#pragma unroll
            for (int ks = 0; ks < 4; ++ks) { const f32x4 g0 = *(const f32x4*)(ap->in[30] + 16 * ks + 8 * hi), g1 = *(const f32x4*)(ap->in[30] + 16 * ks + 8 * hi + 4);
                u32x4 w; w.x = pk2(bflo(raw[ks].x) * rs * g0[0], bfhi(raw[ks].x) * rs * g0[1]); w.y = pk2(bflo(raw[ks].y) * rs * g0[2], bfhi(raw[ks].y) * rs * g0[3]);
                w.z = pk2(bflo(raw[ks].z) * rs * g1[0], bfhi(raw[ks].z) * rs * g1[1]); w.w = pk2(bflo(raw[ks].w) * rs * g1[2], bfhi(raw[ks].w) * rs * g1[3]);
                qf[ks] = __builtin_bit_cast(bf16x8, w); }
        }
        const float gt0 = gtn0, gt1 = gtn1, gt2 = gtn2;
        __syncthreads();
        const LAS float* biasr = BIAS + r * 128;
        LAS float* TOT = (LAS float*)(lds + AT_TOT) + wave * 2048 + lane;
        {
            f32x16 s[4];
            const bf16* kc = KC + (size_t)(bg * 128) * 64;
            {
#pragma unroll
                for (int kh = 0; kh < 2; ++kh) {
                    bf16x8 kf[8];
#pragma unroll
                    for (int k2 = 0; k2 < 2; ++k2)
#pragma unroll
                        for (int ks = 0; ks < 4; ++ks) kf[k2 * 4 + ks] = *(const bf16x8*)(kc + (size_t)(32 * (2 * kh + k2) + ql) * 64 + 16 * ks + 8 * hi);
                    __builtin_amdgcn_sched_barrier(0);
#pragma unroll
                    for (int k2 = 0; k2 < 2; ++k2) {
#pragma unroll
                        for (int i = 0; i < 16; ++i) s[2 * kh + k2][i] = sh_cmp;
#pragma unroll
                        for (int ks = 0; ks < 4; ++ks) s[2 * kh + k2] = MFMA32(kf[k2 * 4 + ks], qf[ks], s[2 * kh + k2]);
                    }
                }
            }
            float l = 0.f;
            const int D0 = tq - 31 - 64 * hi;
#pragma unroll
            for (int kt = 0; kt < 4; ++kt)
#pragma unroll
                for (int i = 0; i < 16; ++i) {
                    const int dist = D0 - 16 * (32 * kt + (i & 3) + 8 * (i >> 2));
                    const bool valid = dist >= 0;
                    const int di = dist < 0 ? 0 : (dist > 127 ? 127 : dist);
                    const float pv = valid ? __builtin_amdgcn_exp2f(s[kt][i] + biasr[di]) : 0.f;
                    s[kt][i] = pv; l += pv;
                }
            l += __shfl_xor(l, 32);
            const float inv = l > 0.f ? 1.0f / l : 0.f;
            {
                LAS float* pslr = PSL + (r * 64 + th * 32 + ql) * 36;
                float prev = 0.f;
#pragma unroll
                for (int m = 0; m < 16; ++m) {
                    const int kt = m >> 2, i0 = 4 * (m & 3);
                    const float half3 = 0.5f * s[kt][i0 + 3];
                    const float own = (s[kt][i0] + s[kt][i0 + 1]) + (s[kt][i0 + 2] + half3);
                    const float other = __shfl_xor(half3, 32);
                    const float add = hi ? other : prev;
                    prev = other;
                    pslr[2 * m + hi] = (own + add) * inv;
                }
            }
            f32x16 o[2];
#pragma unroll
            for (int i = 0; i < 16; ++i) { o[0][i] = 0.f; o[1][i] = 0.f; }
            const bf16* vc = VC + (size_t)(bg * 64) * 128;
#pragma unroll
            for (int kh = 0; kh < 2; ++kh) {
                u32x2 vlo[8], vhi[8];
#pragma unroll
                for (int k2 = 0; k2 < 2; ++k2)
#pragma unroll
                    for (int s2 = 0; s2 < 2; ++s2)
#pragma unroll
                        for (int mt = 0; mt < 2; ++mt) { const bf16* vb = vc + (size_t)(32 * mt + ql) * 128 + 32 * (2 * kh + k2) + 16 * s2 + 4 * hi;
                            vlo[(k2 * 2 + s2) * 2 + mt] = *(const u32x2*)vb; vhi[(k2 * 2 + s2) * 2 + mt] = *(const u32x2*)(vb + 8); }
                __builtin_amdgcn_sched_barrier(0);
#pragma unroll
                for (int k2 = 0; k2 < 2; ++k2)
#pragma unroll
                    for (int s2 = 0; s2 < 2; ++s2) {
                        const bf16x8 pb = pack8(s[2 * kh + k2], s2);
#pragma unroll
                        for (int mt = 0; mt < 2; ++mt) {
                            const u32x2 lo = vlo[(k2 * 2 + s2) * 2 + mt], hi2 = vhi[(k2 * 2 + s2) * 2 + mt];
                            u32x4 w; w.x = lo.x; w.y = lo.y; w.z = hi2.x; w.w = hi2.y;
                            o[mt] = MFMA32(__builtin_bit_cast(bf16x8, w), pb, o[mt]);
                        }
                    }
            }
            const float sc = gt0 * inv;
#pragma unroll
            for (int i = 0; i < 16; ++i) { TOT[i * 64] = sc * o[0][i]; TOT[(16 + i) * 64] = sc * o[1][i]; }
        }
        __syncthreads();
        {
            const int tok = tid >> 3, jg = tid & 7, cur = qt;
            float v[32];
#pragma unroll
            for (int q = 0; q < 8; ++q) {
                const f32x4 a0 = *(const LAS f32x4*)(PSL + (0 * 64 + tok) * 36 + 4 * q), a1 = *(const LAS f32x4*)(PSL + (1 * 64 + tok) * 36 + 4 * q);
                const f32x4 a2 = *(const LAS f32x4*)(PSL + (2 * 64 + tok) * 36 + 4 * q), a3 = *(const LAS f32x4*)(PSL + (3 * 64 + tok) * 36 + 4 * q);
#pragma unroll
                for (int e = 0; e < 4; ++e) v[4 * q + e] = (a0[e] + a1[e]) + (a2[e] + a3[e]);
            }
            const unsigned forced = 1u | (1u << cur) | (cur > 0 ? (1u << (cur - 1)) : 0u);
            const int need = 8 - __popc(forced);
            unsigned bits = 0u;
#pragma unroll
            for (int e = 0; e < 4; ++e) {
                float mine = 0.f;
#pragma unroll
                for (int q = 0; q < 8; ++q) mine = (jg == q) ? v[4 * q + e] : mine;
                const int j = 4 * jg + e;
                int rank = 0;
#pragma unroll
                for (int jp = 1; jp < 30; ++jp) { const bool cand = jp <= cur - 2; const bool ahead = (v[jp] > mine) || (v[jp] == mine && jp < j); rank += (cand && ahead) ? 1 : 0; }
                if (j >= 1 && j <= cur - 2 && rank < need) bits |= 1u << j;
            }
            bits |= __shfl_xor(bits, 1); bits |= __shfl_xor(bits, 2); bits |= __shfl_xor(bits, 4);
            if (jg == 0) SEL[tok] = forced | bits;
        }
        __syncthreads();
        const unsigned selm = SEL[th * 32 + ql];
        {
            f32x16 o[2]; float l;
            u32x4 kst[2], vst[2];
            attn_first_load<0>(KN + (size_t)((0 * 32 + b) * 4 + g) * SEQ * 64, VTg + (size_t)((0 * 32 + b) * 4 + g) * 64 * SEQ, qt, tid, kst, vst);
            attn_loop<0>(lds, KN + (size_t)((0 * 32 + b) * 4 + g) * SEQ * 64, VTg + (size_t)((0 * 32 + b) * 4 + g) * 64 * SEQ, qt, tq, selm, qf, biasr, sh_slc, o, l, tid, ql, hi, kst, vst);
            attn_first_load<1>(KN + (size_t)((1 * 32 + b) * 4 + g) * SEQ * 64, VTg + (size_t)((1 * 32 + b) * 4 + g) * 64 * SEQ, qt, tid, kst, vst);
            const float sc = gt1 / l;
#pragma unroll
            for (int i = 0; i < 16; ++i) { TOT[i * 64] += sc * o[0][i]; TOT[(16 + i) * 64] += sc * o[1][i]; }
            attn_loop<1>(lds, KN + (size_t)((1 * 32 + b) * 4 + g) * SEQ * 64, VTg + (size_t)((1 * 32 + b) * 4 + g) * 64 * SEQ, qt, tq, selm, qf, biasr, sh_win, o, l, tid, ql, hi, kst, vst);
            const float sc2 = gt2 / l;
#pragma unroll
            for (int i = 0; i < 16; ++i) { o[0][i] = TOT[i * 64] + sc2 * o[0][i]; o[1][i] = TOT[(16 + i) * 64] + sc2 * o[1][i]; }
            if (u + G < 4096) ATT_QLOAD(u + G);
            LAS unsigned char* ost = lds + AT_TOT + wave * 8192;
            LDS_WAIT();
#pragma unroll
            for (int mt = 0; mt < 2; ++mt)
#pragma unroll
                for (int q4 = 0; q4 < 4; ++q4) { u32x2 w; w.x = pk2(o[mt][4 * q4], o[mt][4 * q4 + 1]); w.y = pk2(o[mt][4 * q4 + 2], o[mt][4 * q4 + 3]); *(LAS u32x2*)(ost + ql * AT_STRIDE + (32 * mt + 8 * q4 + 4 * hi) * 2) = w; }
            LDS_WAIT();
            bf16* op = Ob + (size_t)(b * SEQ + qt * 64 + th * 32) * DM + h * 64;
#pragma unroll
            for (int it = 0; it < 4; ++it) { const int row = it * 8 + (lane >> 3), ch = lane & 7; const u32x4 w = *(const LAS u32x4*)(ost + row * AT_STRIDE + ch * 16); *(u32x4*)(op + (size_t)row * DM + ch * 8) = w; }
            LDS_WAIT();
        }
    }
}
#define XB_TMO      128
#define XB_XCNT(j)  (256  + 64 * (j))
#define XB_XSUB(j)  (1280 + 64 * (j))
#define XB_XGEN(j)  (2304 + 64 * (j))
#define XB_TOP      3328
#define XB_TOPGEN   3392
#define XCD_BAR_WORDS 3456
#define XB_SPIN_CAP (1u << 18)

__device__ __forceinline__ unsigned xb_ld(unsigned* p)              { return __hip_atomic_load(p, __ATOMIC_RELAXED, __HIP_MEMORY_SCOPE_AGENT); }
__device__ __forceinline__ unsigned xb_add(unsigned* p, unsigned v) { return __hip_atomic_fetch_add(p, v, __ATOMIC_RELAXED, __HIP_MEMORY_SCOPE_AGENT); }
__device__ __forceinline__ unsigned xb_xcc_id() { return (unsigned)__builtin_amdgcn_s_getreg((3 << 11) | 20) & 0xFu; }
#define XB_SPIN(cond, bar) do { unsigned _sp = 0; while (cond) { __builtin_amdgcn_s_sleep(1); \
    if ((++_sp & 255u) == 0u) { if (xb_ld(&(bar)[XB_TMO])) break; if (_sp > XB_SPIN_CAP) { atomicAdd(&(bar)[XB_TMO], 1u); break; } } } } while (0)

struct XcdBarrier {
    unsigned* bar; unsigned x;
    volatile LAS unsigned* st;
};

__device__ __forceinline__ XcdBarrier xcd_barrier_post(unsigned* bar, volatile LAS unsigned* st) {
    XcdBarrier b; b.bar = bar; b.x = xb_xcc_id(); b.st = st;
    if (threadIdx.x == 0) (void)xb_add(&bar[XB_XCNT(b.x)], 1u);
    return b;
}
__device__ __forceinline__ void xcd_barrier_complete(unsigned* bar, unsigned x, unsigned& nloc, unsigned& nx) {
    const unsigned G = gridDim.x * gridDim.y * gridDim.z;
    unsigned sum, cnt, mine, sp = 0u;
    for (;;) {
        sum = 0u; cnt = 0u; mine = 0u;
#pragma unroll
        for (unsigned j = 0; j < 16; ++j) { const unsigned c = xb_ld(&bar[XB_XCNT(j)]); sum += c; cnt += (c > 0u) ? 1u : 0u; mine = (j == x) ? c : mine; }
        if (sum == G) break;
        __builtin_amdgcn_s_sleep(1);
        if ((++sp & 255u) == 0u) { if (xb_ld(&bar[XB_TMO])) break; if (sp > XB_SPIN_CAP) { atomicAdd(&bar[XB_TMO], 1u); break; } }
    }
    nloc = mine > 0u ? mine : 1u; nx = cnt > 0u ? cnt : 1u;
}

__device__ __forceinline__ void xcd_barrier(const XcdBarrier& b) {
    asm volatile("s_waitcnt vmcnt(0)" ::: "memory");
    __syncthreads();
    if (threadIdx.x == 0) {
        unsigned* bar = b.bar;
        __builtin_amdgcn_s_waitcnt(0);
        unsigned nloc = b.st[0], nx = b.st[1];
        if (nloc == 0u) { xcd_barrier_complete(bar, b.x, nloc, nx); b.st[0] = nloc; b.st[1] = nx; }
        const unsigned old = xb_add(&bar[XB_XSUB(b.x)], 1u);
        const unsigned gen = old / nloc;
        if (old + 1u == (gen + 1u) * nloc) {
            __builtin_amdgcn_fence(__ATOMIC_RELEASE, "agent");
            asm volatile("s_waitcnt vmcnt(0)" ::: "memory");
            const unsigned og = xb_add(&bar[XB_TOP], 1u);
            const unsigned tg = og / nx;
            if (og + 1u == (tg + 1u) * nx) xb_add(&bar[XB_TOPGEN], 1u);
            else XB_SPIN(xb_ld(&bar[XB_TOPGEN]) == tg, bar);
            __builtin_amdgcn_fence(__ATOMIC_ACQUIRE, "agent");
            xb_add(&bar[XB_XGEN(b.x)], 1u);
            asm volatile("s_waitcnt vmcnt(0)" ::: "memory");
        } else {
            XB_SPIN(xb_ld(&bar[XB_XGEN(b.x)]) == gen, bar);
            __builtin_amdgcn_fence(__ATOMIC_ACQUIRE, "agent");
            asm volatile("s_waitcnt vmcnt(0)" ::: "memory");
        }
    }
    __syncthreads();
}

__global__ void __launch_bounds__(512, 2) yoco_fwd(Args a_unused) {
    extern __shared__ __attribute__((aligned(16))) unsigned char lds_raw[];
    LAS unsigned char* lds = (LAS unsigned char*)lds_raw;
    KArgs ap = (KArgs)__builtin_amdgcn_kernarg_segment_ptr();
    const int ph_lo = ap->ph_lo, ph_hi = ap->ph_hi;
    if (threadIdx.x < 2) ((LAS unsigned*)(lds + MISC_OFF))[threadIdx.x] = 0u;
    __syncthreads();
    (void)xcd_barrier_post((unsigned*)(ap->ws + WS_BAR), (volatile LAS unsigned*)(lds + MISC_OFF));
    if (ph_lo < 0) cg::this_grid().sync();
    for (int pi = ph_lo; pi < ph_hi; ++pi) {
        asm volatile("" : "+s"(ap));
        const int code = ap->seq[pi];
        const int kind = code & 15, f = (code >> 4) & 3, half = (code >> 6) & 1, nobar = code >> 7;
        int tid = threadIdx.x; asm volatile("" : "+v"(tid));
        int G = gridDim.x, bx = blockIdx.x; asm volatile("" : "+s"(G), "+s"(bx));
        const int lane = tid & 63, wave = __builtin_amdgcn_readfirstlane(tid >> 6);
        const int vcu = (G % 8 == 0) ? (bx % 8) * (G / 8) + bx / 8 : bx;
        const int gw = vcu * 8 + wave, NGW = G * 8;
        unsigned char* ws = ap->ws;
        bf16* HB = (bf16*)(ws + WS_HB); bf16* HID = (bf16*)(ws + WS_HID);
        switch (kind) {
        case 0: p0_prologue(ap, lds, vcu, G, wave, lane, tid); break;
        case 1: {
            const int rpi = f == 0 ? 0 : (f == 1 ? 2 : (f == 2 ? 3 : 5));
            pg8::Gemm g{HB, (const bf16*)(ws + WS_WIN + (size_t)f * 11 * MiB), NT / 2, 2 * FF, DM}; pg8::StaticOrder S; S.init(NT / 2, 2 * FF, G, bx, half * (NT / 512));
            pg8::EpiSwiglu E{HID, FF, (const float*)(ws + WS_RP + (size_t)rpi * 4 * MiB)};
            pg8::gemm_phase<pg8::EpiSwiglu, pg8::StaticOrder, true, true>(lds, g, S, E, tid);
        } break;
        case 2: case 9: {
            pg8::Gemm g; float scale = 0.5f; int rpo = 1; pg8::StaticOrder S;
            if (kind == 9) { g = pg8::Gemm{(const bf16*)(ws + WS_O), (const bf16*)(ws + WS_WO), NT, DM, DM}; scale = 1.0f; rpo = 5; S.init(NT, DM, G, bx); }
            else { rpo = f == 0 ? 1 : (f == 1 ? 3 : 4); g = pg8::Gemm{HID, (const bf16*)(ws + WS_WOUT + (size_t)f * (11 * MiB / 2)), NT / 2, DM, FF, 1}; S.init(NT / 2, DM, G, bx, half * (NT / 512)); }
            pg8::EpiResid E{HB, (float*)(ws + WS_RP + (size_t)rpo * 4 * MiB), ap->out, scale, (kind == 2 && f == 3) ? 1 : 0, (LAS float*)(lds + 131072), tid};
            pg8::gemm_phase<pg8::EpiResid, pg8::StaticOrder, true, true>(lds, g, S, E, tid);
        } break;
        case 3: s5_phase(ap, lds, vcu, G, wave, lane, tid); break;
        case 4: {
            pg8::Gemm g{(const bf16*)(ws + WS_Z), (const bf16*)(ws + WS_WGLU), NT, DM, DM}; pg8::StaticOrder S; S.init(NT, DM, G, bx);
            pg8::EpiGlu E{HB, (const bf16*)(ws + WS_Z), (float*)(ws + WS_RP + 2 * 4 * MiB), (LAS float*)(lds + 131072), tid};
            pg8::gemm_phase<pg8::EpiGlu, pg8::StaticOrder, true, true>(lds, g, S, E, tid);
        } break;
        case 5: {
            pg8::Gemm g{HB, (const bf16*)(ws + WS_WKV), NT, 1536, DM}; pg8::StaticOrder S; S.init(NT, 1536, G, bx);
            pg8::EpiPlain E{(bf16*)(ws + WS_KV), NT, (const float*)(ws + WS_RP + 3 * 4 * MiB)};
            pg8::gemm_phase<pg8::EpiPlain, pg8::StaticOrder, true, true>(lds, g, S, E, tid);
        } break;
        case 6: {
            kvpost_phase(ap, lds, gw, NGW, wave, lane);
            compress_phase(ap, lds, vcu, G, wave, lane);
            __syncthreads();
        } break;
        case 7: {
            pg8::Gemm g{HB, (const bf16*)(ws + WS_WQG), NT, 1280, DM}; pg8::StaticOrder S; S.init(NT, 1280, G, bx);
            pg8::EpiQG E{(bf16*)(ws + WS_Q), (float*)(ws + WS_GATES), (const float*)(ws + WS_RP + 4 * 4 * MiB)};
            pg8::gemm_phase<pg8::EpiQG, pg8::StaticOrder, true, true>(lds, g, S, E, tid);
        } break;
        case 8: attn_phase(ap, lds, vcu, G, wave, lane, tid); break;
        default: break;
        }
        if (!nobar && pi + 1 < ph_hi) { XcdBarrier xb; xb.bar = (unsigned*)(ap->ws + WS_BAR); xb.x = xb_xcc_id(); xb.st = (volatile LAS unsigned*)(lds + MISC_OFF); xcd_barrier(xb); }
    }
}

#ifndef N_LAUNCH_MODE
#define N_LAUNCH_MODE 0
#endif
extern "C" void kernel_launch(void* const* d_in, const int* in_sizes, int n_in, void* d_out, int out_size, void* d_ws, size_t ws_size, hipStream_t stream) {
    static int grid = 0;
    if (grid == 0) {
        if (n_in != 32 || out_size != NT * DM || ws_size < WS_END) { fprintf(stderr, "kernel_launch: unexpected shapes (n_in %d out %d ws %zu)\n", n_in, out_size, ws_size); grid = -1; return; }
        int dev = 0, cus = 0, per_cu = 0;
        hipGetDevice(&dev); hipDeviceGetAttribute(&cus, hipDeviceAttributeMultiprocessorCount, dev);
        if (hipFuncSetAttribute((const void*)yoco_fwd, hipFuncAttributeMaxDynamicSharedMemorySize, LDS_BYTES) != hipSuccess) { fprintf(stderr, "kernel_launch: hipFuncSetAttribute failed\n"); grid = -1; return; }
        if (hipOccupancyMaxActiveBlocksPerMultiprocessor(&per_cu, (const void*)yoco_fwd, 512, LDS_BYTES) != hipSuccess || per_cu < 1) { fprintf(stderr, "kernel_launch: occupancy query gave %d\n", per_cu); per_cu = 1; }
        (void)hipGetLastError();
        grid = cus * per_cu;
        if (grid > 256) grid = 256;
    }
    if (grid < 0) return;
#ifndef PROBE_MASK
#define PROBE_MASK 0u
#endif
    if (hipMemsetAsync((char*)d_ws + WS_BAR, 0, 16384, stream) != hipSuccess) { fprintf(stderr, "kernel_launch: memset of barrier words failed\n"); return; }
    static Args as[NPHASE + 1];
    unsigned char seq[32]; int nseq = 0;
    auto T = [&](int kind, int f, int half, int nobar) { seq[nseq++] = (unsigned char)(kind | (f << 4) | (half << 6) | (nobar << 7)); };
    T(0, 0, 0, 0);
    T(1, 0, 0, 0); T(2, 0, 0, 1); T(1, 0, 1, 0); T(2, 0, 1, 0);
    T(3, 0, 0, 0); T(4, 0, 0, 0);
    T(1, 1, 0, 0); T(2, 1, 0, 1); T(1, 1, 1, 0); T(2, 1, 1, 0);
    T(5, 0, 0, 1); T(1, 2, 0, 0);
    T(6, 0, 0, 1); T(2, 2, 0, 1); T(1, 2, 1, 0); T(2, 2, 1, 0);
    T(7, 0, 0, 0); T(8, 0, 0, 0); T(9, 0, 0, 0);
    T(1, 3, 0, 0); T(2, 3, 0, 1); T(1, 3, 1, 0); T(2, 3, 1, 0);
    for (int p = nseq; p < 32; ++p) seq[p] = 255;
    for (int li = 0; li < (N_LAUNCH_MODE ? NPHASE : 1); ++li) {
        Args& a = as[li]; a = Args{};
        for (int i = 0; i < 32; ++i) a.in[i] = (const float*)d_in[i];
        a.out = (float*)d_out; a.ws = (unsigned char*)d_ws;
        a.ph_lo = N_LAUNCH_MODE ? li : 0; a.ph_hi = N_LAUNCH_MODE ? li + 1 : nseq;
        for (int p = 0; p < 32; ++p) a.seq[p] = seq[p];
        void* args[] = {&a};
        hipError_t e = hipLaunchCooperativeKernel((const void*)yoco_fwd, dim3(grid), dim3(512), args, LDS_BYTES, stream);
        if (e != hipSuccess) { fprintf(stderr, "cooperative launch %d failed: %s (grid %d)\n", li, hipGetErrorString(e), grid); break; }
    }
}
```

```cpp
#include <hip/hip_runtime.h>
#include <hip/hip_cooperative_groups.h>
#include <cstdio>
#include <cstdint>
namespace cg = cooperative_groups;
namespace pg8 {
#define PG8_LAS __attribute__((address_space(3)))
typedef unsigned short bf16_t;
typedef short bf16x8 __attribute__((ext_vector_type(8)));
typedef float f32x4 __attribute__((ext_vector_type(4)));
typedef unsigned u32x4 __attribute__((ext_vector_type(4)));
constexpr int BM = 256, BK = 64, HALF = 128, HTB = HALF * BK * 2  , STAGE_BYTES = 8 * HTB, NXCD = 8, WGM = 8;

__host__ __device__ __forceinline__ int lds_byte(int r, int c) { const int st = (r >> 4) * 2 + (c >> 5), rr = r & 15, cc = c & 31, ob = rr * 64 + cc * 2; return st * 1024 + (ob ^ (((ob >> 9) & 1) << 5)); }
__host__ __device__ __forceinline__ void stage_rc(int b, int& R, int& C) { const int st = b / 1024, sb = b % 1024, swz = sb ^ (((sb >> 9) & 1) << 5); R = (st >> 1) * 16 + swz / 64; C = (st & 1) * 32 + (swz % 64) / 2; }
__host__ __device__ __forceinline__ int perm32(int rho) { const int n = rho >> 4, i = rho & 15; return 8 * (i >> 2) + 4 * n + (i & 3); }

struct Unit { int pm, pn; };
struct Gemm { const bf16_t* A; const bf16_t* Bt; int M, N, K; int a_tiled; };

struct StaticOrder {
    int nM, nN, nwg, G, c, pm0;
    __host__ __device__ void init(int M, int N, int G_, int c_, int pm0_ = 0) { nM = M / BM; nN = N / BM; nwg = nM * nN; G = G_; c = c_; pm0 = pm0_; }
    __host__ __device__ bool next(int i, Unit& u) const {
        const long L = (long)i * G + c; if (L >= nwg) return false;
        int wgid = (int)L; { const int q = nwg / NXCD, r = nwg % NXCD, xcd = wgid % NXCD, off = wgid / NXCD; wgid = (xcd < r ? xcd * (q + 1) : r * (q + 1) + (xcd - r) * q) + off; }
        const int nig = WGM * nN, gid = wgid / nig, fm = gid * WGM, gsz = (nM - fm) < WGM ? (nM - fm) : WGM;
        u.pm = pm0 + fm + ((wgid % nig) % gsz); u.pn = (wgid % nig) / gsz; return true;
    }
    __device__ __forceinline__ void a_ready(const Unit&) const {}
    __device__ __forceinline__ void done(const Unit&) const {}
};

__device__ __forceinline__ unsigned cvt_pk_bf16(float lo, float hi) { unsigned r; asm volatile("v_cvt_pk_bf16_f32 %0, %1, %2" : "=v"(r) : "v"(lo), "v"(hi)); return r; }
typedef float f32x2 __attribute__((ext_vector_type(2)));
__device__ __forceinline__ float sigmoidf_(float a) { return __builtin_amdgcn_rcpf(1.0f + __expf(-a)); }
__device__ __forceinline__ float row_rstd(const float* rp, int row) {
    const f32x4 a = *(const f32x4*)(rp + (size_t)row * 4);
    const float s = (a[0] + a[1]) + (a[2] + a[3]);
    return __builtin_amdgcn_rsqf(s * (1.0f / 1024.0f) + 1e-6f);
}
struct EpiSwiglu {
    static constexpr bool PERM = true, AFTER_DRAIN = false;
    bf16_t* O; int ldc; const float* rp;
    __device__ __forceinline__ void operator()(const f32x4 (&acc)[2][2][4][2], const Unit& u, int wr, int wc, int fr, int fq) const {
        const int row0 = u.pm * BM + wr * 64 + fr; const int rl0 = wr * 64 + fr;
        bf16_t* tbase = O + ((size_t)u.pm * (ldc / BK) + (size_t)(u.pn * 2 + (wc >> 1))) * (BM * BK) + (wc & 1) * 32 + 8 * fq;
        f32x4 rpv[2][4];
#pragma unroll
        for (int ai = 0; ai < 2; ++ai)
#pragma unroll
            for (int m = 0; m < 4; ++m) rpv[ai][m] = *(const f32x4*)(rp + (size_t)(row0 + ai * HALF + m * 16) * 4);
#pragma unroll
        for (int ai = 0; ai < 2; ++ai)
#pragma unroll
            for (int m = 0; m < 4; ++m) { bf16_t* rowp = tbase + (size_t)(rl0 + ai * HALF + m * 16) * BK;
                const float rs = __builtin_amdgcn_rsqf(((rpv[ai][m][0] + rpv[ai][m][1]) + (rpv[ai][m][2] + rpv[ai][m][3])) * (1.0f / 1024.0f) + 1e-6f);
                f32x4 v[2];
#pragma unroll
                for (int n = 0; n < 2; ++n) { const f32x4 a = acc[ai][0][m][n] * rs, b = acc[ai][1][m][n] * rs;
#pragma unroll
                    for (int j = 0; j < 4; ++j) v[n][j] = a[j] * sigmoidf_(a[j]) * b[j]; }
                u32x4 w; w.x = cvt_pk_bf16(v[0][0], v[0][1]); w.y = cvt_pk_bf16(v[0][2], v[0][3]); w.z = cvt_pk_bf16(v[1][0], v[1][1]); w.w = cvt_pk_bf16(v[1][2], v[1][3]);
                *(u32x4*)rowp = w; }
    }
};
struct EpiPlain {
    static constexpr bool PERM = true, AFTER_DRAIN = false;
    bf16_t* O; int ldc; const float* rp;
    __device__ __forceinline__ void operator()(const f32x4 (&acc)[2][2][4][2], const Unit& u, int wr, int wc, int fr, int fq) const {
        const int row0 = u.pm * BM + wr * 64 + fr; const int col0 = u.pn * BM + wc * 32 + 8 * fq;
        f32x4 rpv[2][4];
#pragma unroll
        for (int ai = 0; ai < 2; ++ai)
#pragma unroll
            for (int m = 0; m < 4; ++m) rpv[ai][m] = *(const f32x4*)(rp + (size_t)(row0 + ai * HALF + m * 16) * 4);
#pragma unroll
        for (int ai = 0; ai < 2; ++ai)
#pragma unroll
            for (int m = 0; m < 4; ++m) { const int row = row0 + ai * HALF + m * 16;
                const float rs = __builtin_amdgcn_rsqf(((rpv[ai][m][0] + rpv[ai][m][1]) + (rpv[ai][m][2] + rpv[ai][m][3])) * (1.0f / 1024.0f) + 1e-6f);
#pragma unroll
                for (int bj = 0; bj < 2; ++bj) { const f32x4 v0 = acc[ai][bj][m][0] * rs, v1 = acc[ai][bj][m][1] * rs;
                    u32x4 w; w.x = cvt_pk_bf16(v0[0], v0[1]); w.y = cvt_pk_bf16(v0[2], v0[3]); w.z = cvt_pk_bf16(v1[0], v1[1]); w.w = cvt_pk_bf16(v1[2], v1[3]);
                    const int col = col0 + bj * HALF;
                    *(u32x4*)(O + ((size_t)(col >> 6) * ldc + row) * 64 + (col & 63)) = w; } }
    }
};
struct EpiQG {
    static constexpr bool PERM = true, AFTER_DRAIN = false;
    bf16_t* Q; float* gates; const float* rp;
    __device__ __forceinline__ void operator()(const f32x4 (&acc)[2][2][4][2], const Unit& u, int wr, int wc, int fr, int fq) const {
        const int row0 = u.pm * BM + wr * 64 + fr;
        float rsv[2][4];
        { f32x4 rpv[2][4];
#pragma unroll
          for (int ai = 0; ai < 2; ++ai)
#pragma unroll
              for (int m = 0; m < 4; ++m) rpv[ai][m] = *(const f32x4*)(rp + (size_t)(row0 + ai * HALF + m * 16) * 4);
#pragma unroll
          for (int ai = 0; ai < 2; ++ai)
#pragma unroll
              for (int m = 0; m < 4; ++m) rsv[ai][m] = __builtin_amdgcn_rsqf(((rpv[ai][m][0] + rpv[ai][m][1]) + (rpv[ai][m][2] + rpv[ai][m][3])) * (1.0f / 1024.0f) + 1e-6f); }
        if (u.pn < 4) {
            const int col0 = u.pn * BM + wc * 32 + 8 * fq;
#pragma unroll
            for (int ai = 0; ai < 2; ++ai)
#pragma unroll
                for (int m = 0; m < 4; ++m) { const int row = row0 + ai * HALF + m * 16; bf16_t* rowp = Q + (size_t)row * 1024 + col0; const float rs = rsv[ai][m];
#pragma unroll
                    for (int bj = 0; bj < 2; ++bj) { const f32x4 v0 = acc[ai][bj][m][0] * rs, v1 = acc[ai][bj][m][1] * rs;
                        u32x4 w; w.x = cvt_pk_bf16(v0[0], v0[1]); w.y = cvt_pk_bf16(v0[2], v0[3]); w.z = cvt_pk_bf16(v1[0], v1[1]); w.w = cvt_pk_bf16(v1[2], v1[3]);
                        *(u32x4*)(rowp + bj * HALF) = w; } }
        } else {
            const int c0 = wc * 32 + 8 * fq;
            if (c0 < 48) {
#pragma unroll
                for (int ai = 0; ai < 2; ++ai)
#pragma unroll
                    for (int m = 0; m < 4; ++m) { const int row = row0 + ai * HALF + m * 16; float* rowp = gates + (size_t)row * 48 + c0; const float rs = rsv[ai][m];
#pragma unroll
                        for (int n = 0; n < 2; ++n) { const f32x4 a = acc[ai][0][m][n] * rs; f32x4 o;
#pragma unroll
                            for (int j = 0; j < 4; ++j) o[j] = sigmoidf_(a[j]);
                            *(f32x4*)(rowp + 4 * n) = o; } }
            }
        }
    }
};
struct EpiResid {
    static constexpr bool PERM = false, AFTER_DRAIN = false;
    bf16_t* hb; float* rpo; float* out; float scale; int fin; PG8_LAS float* X; int tid;
    __device__ __forceinline__ void operator()(const f32x4 (&acc)[2][2][4][2], const Unit& u, int wr, int wc, int fr, int fq) const {
        typedef unsigned u32x2v __attribute__((ext_vector_type(2)));
        const int row0 = u.pm * BM + wr * 64 + fr; const int col0 = u.pn * BM + wc * 32 + 4 * fq;
#pragma unroll
        for (int ai = 0; ai < 2; ++ai) {
            u32x2v hv[4][2][2];
#pragma unroll
            for (int m = 0; m < 4; ++m)
#pragma unroll
                for (int bj = 0; bj < 2; ++bj)
#pragma unroll
                    for (int n = 0; n < 2; ++n) hv[m][bj][n] = *(const u32x2v*)(hb + (size_t)(row0 + ai * HALF + m * 16) * 1024 + col0 + bj * HALF + n * 16);
#pragma unroll
            for (int m = 0; m < 4; ++m) { const int row = row0 + ai * HALF + m * 16; const size_t off = (size_t)row * 1024 + col0; float ss = 0.f;
#pragma unroll
                for (int bj = 0; bj < 2; ++bj)
#pragma unroll
                    for (int n = 0; n < 2; ++n) { const size_t o2 = off + bj * HALF + n * 16; const u32x2v hh = hv[m][bj][n]; const f32x4 a = acc[ai][bj][m][n];
                        f32x4 r; r[0] = __uint_as_float(hh.x << 16) + scale * a[0]; r[1] = __uint_as_float(hh.x & 0xffff0000u) + scale * a[1];
                        r[2] = __uint_as_float(hh.y << 16) + scale * a[2]; r[3] = __uint_as_float(hh.y & 0xffff0000u) + scale * a[3];
                        if (fin) { *(f32x4*)(out + o2) = r; }
                        else { u32x2v w; w.x = cvt_pk_bf16(r[0], r[1]); w.y = cvt_pk_bf16(r[2], r[3]); *(u32x2v*)(hb + o2) = w;
                            const float q0 = __uint_as_float(w.x << 16), q1 = __uint_as_float(w.x & 0xffff0000u), q2 = __uint_as_float(w.y << 16), q3 = __uint_as_float(w.y & 0xffff0000u);
                            ss += (q0 * q0 + q1 * q1) + (q2 * q2 + q3 * q3); } }
                if (!fin) { ss += __shfl_xor(ss, 16); ss += __shfl_xor(ss, 32); if (fq == 0) X[(ai * HALF + wr * 64 + m * 16 + fr) * 4 + wc] = ss; } }
            asm volatile("" ::: "memory"); }
        if (!fin) { asm volatile("s_waitcnt lgkmcnt(0)" ::: "memory"); __builtin_amdgcn_s_barrier(); asm volatile("" ::: "memory");
            if (tid < 256) { const f32x4 v = *(const PG8_LAS f32x4*)(X + tid * 4); rpo[(size_t)(u.pm * BM + tid) * 4 + u.pn] = (v[0] + v[1]) + (v[2] + v[3]); } }
    }
};
struct EpiGlu {
    static constexpr bool PERM = false, AFTER_DRAIN = false;
    bf16_t* hb; const bf16_t* z; float* rpo; PG8_LAS float* X; int tid;
    __device__ __forceinline__ void operator()(const f32x4 (&acc)[2][2][4][2], const Unit& u, int wr, int wc, int fr, int fq) const {
        typedef unsigned u32x2v __attribute__((ext_vector_type(2)));
        const int row0 = u.pm * BM + wr * 64 + fr; const int col0 = u.pn * BM + wc * 32 + 4 * fq;
#pragma unroll
        for (int ai = 0; ai < 2; ++ai) {
            u32x2v hv[4][2][2], zv[4][2][2];
#pragma unroll
            for (int m = 0; m < 4; ++m)
#pragma unroll
                for (int bj = 0; bj < 2; ++bj)
#pragma unroll
                    for (int n = 0; n < 2; ++n) { const size_t o2 = (size_t)(row0 + ai * HALF + m * 16) * 1024 + col0 + bj * HALF + n * 16; hv[m][bj][n] = *(const u32x2v*)(hb + o2); zv[m][bj][n] = *(const u32x2v*)(z + o2); }
#pragma unroll
            for (int m = 0; m < 4; ++m) { const int row = row0 + ai * HALF + m * 16; const size_t off = (size_t)row * 1024 + col0; float ss = 0.f;
#pragma unroll
                for (int bj = 0; bj < 2; ++bj)
#pragma unroll
                    for (int n = 0; n < 2; ++n) { const size_t o2 = off + bj * HALF + n * 16; const u32x2v hh = hv[m][bj][n]; const u32x2v zz = zv[m][bj][n];
                        const f32x4 a = acc[ai][bj][m][n]; f32x4 r;
                        r[0] = __uint_as_float(hh.x << 16) + __uint_as_float(zz.x << 16) * sigmoidf_(a[0]); r[1] = __uint_as_float(hh.x & 0xffff0000u) + __uint_as_float(zz.x & 0xffff0000u) * sigmoidf_(a[1]);
                        r[2] = __uint_as_float(hh.y << 16) + __uint_as_float(zz.y << 16) * sigmoidf_(a[2]); r[3] = __uint_as_float(hh.y & 0xffff0000u) + __uint_as_float(zz.y & 0xffff0000u) * sigmoidf_(a[3]);
                        u32x2v w; w.x = cvt_pk_bf16(r[0], r[1]); w.y = cvt_pk_bf16(r[2], r[3]); *(u32x2v*)(hb + o2) = w;
                        const float q0 = __uint_as_float(w.x << 16), q1 = __uint_as_float(w.x & 0xffff0000u), q2 = __uint_as_float(w.y << 16), q3 = __uint_as_float(w.y & 0xffff0000u);
                        ss += (q0 * q0 + q1 * q1) + (q2 * q2 + q3 * q3); }
                ss += __shfl_xor(ss, 16); ss += __shfl_xor(ss, 32); if (fq == 0) X[(ai * HALF + wr * 64 + m * 16 + fr) * 4 + wc] = ss; }
            asm volatile("" ::: "memory"); }
        asm volatile("s_waitcnt lgkmcnt(0)" ::: "memory"); __builtin_amdgcn_s_barrier(); asm volatile("" ::: "memory");
        if (tid < 256) { const f32x4 v = *(const PG8_LAS f32x4*)(X + tid * 4); rpo[(size_t)(u.pm * BM + tid) * 4 + u.pn] = (v[0] + v[1]) + (v[2] + v[3]); }
    }
};
template <class Epi, class Sched, bool ALIGN_EPI = false, bool SP2 = false>
__device__ __forceinline__ void gemm_phase(PG8_LAS unsigned char* lds, const Gemm g, const Sched& S, const Epi& E, const int tid) {
    const int wid = __builtin_amdgcn_readfirstlane(tid >> 6), lane = tid & 63, wr = wid >> 2, wc = wid & 3, fr = lane & 15, fq = lane >> 4;
    const int K = g.K, nt = K / BK;
    unsigned voffA[2], voffB[2];
#pragma unroll
    for (int i = 0; i < 2; ++i) { int R, C; stage_rc(tid * 16 + i * 8192, R, C); const int Rb = Epi::PERM ? ((R & ~31) + perm32(R & 31)) : R;
        voffA[i] = (unsigned)(R * (g.a_tiled ? BK : K) + C) * 2u; voffB[i] = (unsigned)(Rb * K + C) * 2u; }
    const size_t kstepB = (size_t)(BK * 2), hstepB = (size_t)HALF * K * 2, tstepB = 2 * hstepB;
    const size_t kstepA = g.a_tiled ? (size_t)(BM * BK * 2) : kstepB, hstepA = g.a_tiled ? (size_t)(HALF * BK * 2) : hstepB, tstepA = g.a_tiled ? (size_t)nt * (BM * BK * 2) : tstepB;
    const unsigned ldsw = (unsigned)wid * 1024u;
    const int aoff = lds_byte(wr * 64 + fr, fq * 8), boff = lds_byte(wc * 32 + fr, fq * 8);
#define PG8_SA(b, h) (((b) * 2 + (h)) * HTB)
#define PG8_SB(b, h) ((4 + (b) * 2 + (h)) * HTB)
#define PG8_STAGE(bufoff, gbase, voff) do { _Pragma("unroll") for (int _i = 0; _i < 2; ++_i) \
        __builtin_amdgcn_global_load_lds((const unsigned*)((const char*)(gbase) + (voff)[_i]), (PG8_LAS unsigned*)(lds + (bufoff) + ldsw + _i * 8192), 16, 0, 0); } while (0)
#define PG8_LDA(dst, b, h) do { _Pragma("unroll") for (int m = 0; m < 4; ++m) _Pragma("unroll") for (int k = 0; k < 2; ++k) dst[m][k] = *(const PG8_LAS bf16x8*)(lds + PG8_SA(b, h) + aoff + m * 2048 + k * 1024); } while (0)
#define PG8_LDB(dst, b, h) do { _Pragma("unroll") for (int n = 0; n < 2; ++n) _Pragma("unroll") for (int k = 0; k < 2; ++k) dst[n][k] = *(const PG8_LAS bf16x8*)(lds + PG8_SB(b, h) + boff + n * 2048 + k * 1024); } while (0)
#define PG8_MMA(ai, bj, At, Bt) do { __builtin_amdgcn_s_setprio(1); _Pragma("unroll") for (int m = 0; m < 4; ++m) _Pragma("unroll") for (int n = 0; n < 2; ++n) _Pragma("unroll") for (int k = 0; k < 2; ++k) \
        acc[ai][bj][m][n] = __builtin_amdgcn_mfma_f32_16x16x32_bf16(Bt[n][k], At[m][k], acc[ai][bj][m][n], 0, 0, 0); __builtin_amdgcn_s_setprio(0); } while (0)
#define PG8_WAIT_V(n) asm volatile("s_waitcnt vmcnt(" #n ")" ::: "memory")
#define PG8_WAIT_L(n) asm volatile("s_waitcnt lgkmcnt(" #n ")" ::: "memory")
#define PG8_BAR __builtin_amdgcn_s_barrier()
#define PG8_SCHED __builtin_amdgcn_sched_barrier(0)
    Unit cur, nxt; int ui = 0;
    if (!S.next(0, cur)) return;
    f32x4 acc[2][2][4][2];
#pragma unroll
    for (int a = 0; a < 2; ++a)
#pragma unroll
        for (int b = 0; b < 2; ++b)
#pragma unroll
            for (int m = 0; m < 4; ++m)
#pragma unroll
                for (int n = 0; n < 2; ++n) acc[a][b][m][n] = (f32x4){0.f, 0.f, 0.f, 0.f};
    bf16x8 At[4][2], B0[2][2], B1[2][2];
    const char* cA = (const char*)g.A + (size_t)cur.pm * tstepA; const char* cB = (const char*)g.Bt + (size_t)cur.pn * tstepB;
    S.a_ready(cur);
    if constexpr (SP2) {
        PG8_STAGE(PG8_SB(0, 0), cB, voffB); PG8_STAGE(PG8_SB(0, 1), cB + hstepB, voffB); PG8_STAGE(PG8_SA(0, 0), cA, voffA); PG8_STAGE(PG8_SA(0, 1), cA + hstepA, voffA);
        if (wr == 1) PG8_BAR;
        PG8_WAIT_V(2); PG8_BAR;
        PG8_STAGE(PG8_SB(1, 0), cB + kstepB, voffB); PG8_STAGE(PG8_SA(1, 0), cA + kstepA, voffA); PG8_STAGE(PG8_SB(1, 1), cB + hstepB + kstepB, voffB);
        PG8_WAIT_V(6); PG8_BAR;
    } else {
        PG8_STAGE(PG8_SB(0, 0), cB, voffB); PG8_STAGE(PG8_SA(0, 0), cA, voffA); PG8_STAGE(PG8_SB(0, 1), cB + hstepB, voffB); PG8_STAGE(PG8_SA(0, 1), cA + hstepA, voffA);
        if (wr == 1) PG8_BAR;
        PG8_WAIT_V(4); PG8_BAR;
        PG8_STAGE(PG8_SB(1, 0), cB + kstepB, voffB); PG8_STAGE(PG8_SA(1, 0), cA + kstepA, voffA); PG8_STAGE(PG8_SB(1, 1), cB + hstepB + kstepB, voffB);
        PG8_WAIT_V(6); PG8_BAR;
    }
    for (;;) {
        const bool has_next = S.next(ui + 1, nxt);
        const char* nA = has_next ? (const char*)g.A + (size_t)nxt.pm * tstepA : cA; const char* nB = has_next ? (const char*)g.Bt + (size_t)nxt.pn * tstepB : cB;
        for (int t = 0; t < nt; t += 2) {
            const bool last = (t == nt - 2);
            const char* a1 = cA + (size_t)(t + 1) * kstepA;
            const char* a2 = last ? nA : cA + (size_t)(t + 2) * kstepA; const char* b2 = last ? nB : cB + (size_t)(t + 2) * kstepB;
            const char* a3 = a2 + kstepA; const char* b3 = b2 + kstepB;
            if (last && has_next) S.a_ready(nxt);
            if constexpr (SP2) {
            PG8_LDB(B0, 0, 0); PG8_LDB(B1, 0, 1); PG8_SCHED; PG8_LDA(At, 0, 0); PG8_STAGE(PG8_SA(1, 1), a1 + hstepA, voffA);
            PG8_WAIT_V(8); PG8_WAIT_L(0); PG8_BAR; PG8_MMA(0, 0, At, B0); PG8_MMA(0, 1, At, B1); PG8_BAR; PG8_SCHED;
            PG8_LDA(At, 0, 1); PG8_STAGE(PG8_SB(0, 0), b2, voffB); PG8_STAGE(PG8_SB(0, 1), b2 + hstepB, voffB); PG8_STAGE(PG8_SA(0, 0), a2, voffA);
            PG8_WAIT_V(8); PG8_WAIT_L(0); PG8_BAR; PG8_MMA(1, 0, At, B0); PG8_MMA(1, 1, At, B1); PG8_BAR; PG8_SCHED;
            PG8_LDB(B0, 1, 0); PG8_LDB(B1, 1, 1); PG8_SCHED; PG8_LDA(At, 1, 0); PG8_STAGE(PG8_SA(0, 1), a2 + hstepA, voffA);
            PG8_WAIT_V(8); PG8_WAIT_L(0); PG8_BAR; PG8_MMA(0, 0, At, B0); PG8_MMA(0, 1, At, B1); PG8_BAR; PG8_SCHED;
            PG8_LDA(At, 1, 1); PG8_STAGE(PG8_SB(1, 0), b3, voffB); PG8_STAGE(PG8_SB(1, 1), b3 + hstepB, voffB); PG8_STAGE(PG8_SA(1, 0), a3, voffA);
            PG8_WAIT_V(8); PG8_WAIT_L(0); PG8_BAR; PG8_MMA(1, 0, At, B0); PG8_MMA(1, 1, At, B1); PG8_BAR; PG8_SCHED;
            } else {
            PG8_LDB(B0, 0, 0); PG8_SCHED; PG8_LDA(At, 0, 0); PG8_STAGE(PG8_SA(1, 1), a1 + hstepA, voffA);
            PG8_WAIT_L(8); PG8_BAR; PG8_WAIT_L(0); PG8_MMA(0, 0, At, B0); PG8_BAR; PG8_SCHED;
            PG8_LDB(B1, 0, 1); PG8_STAGE(PG8_SB(0, 0), b2, voffB);
            PG8_BAR; PG8_WAIT_L(0); PG8_MMA(0, 1, At, B1); PG8_BAR;
            PG8_LDA(At, 0, 1); PG8_STAGE(PG8_SA(0, 0), a2, voffA);
            PG8_BAR; PG8_WAIT_L(0); PG8_MMA(1, 0, At, B0); PG8_BAR; PG8_SCHED;
            PG8_STAGE(PG8_SB(0, 1), b2 + hstepB, voffB);
            PG8_WAIT_V(6); PG8_BAR; PG8_MMA(1, 1, At, B1); PG8_BAR;
            PG8_LDB(B0, 1, 0); PG8_SCHED; PG8_LDA(At, 1, 0); PG8_STAGE(PG8_SA(0, 1), a2 + hstepA, voffA);
            PG8_WAIT_L(8); PG8_BAR; PG8_WAIT_L(0); PG8_MMA(0, 0, At, B0); PG8_BAR; PG8_SCHED;
            PG8_LDB(B1, 1, 1); PG8_STAGE(PG8_SB(1, 0), b3, voffB);
            PG8_BAR; PG8_WAIT_L(0); PG8_MMA(0, 1, At, B1); PG8_BAR;
            PG8_LDA(At, 1, 1); PG8_STAGE(PG8_SA(1, 0), a3, voffA);
            PG8_BAR; PG8_WAIT_L(0); PG8_MMA(1, 0, At, B0); PG8_BAR; PG8_SCHED;
            PG8_STAGE(PG8_SB(1, 1), b3 + hstepB, voffB);
            PG8_WAIT_V(6); PG8_BAR; PG8_MMA(1, 1, At, B1); PG8_BAR;
            }
        }
        if constexpr (ALIGN_EPI) { if (wr == 0) PG8_BAR; }
        if constexpr (!Epi::AFTER_DRAIN) { E(acc, cur, wr, wc, fr, fq); S.done(cur); }
        if (!has_next) break;
#pragma unroll
        for (int a = 0; a < 2; ++a)
#pragma unroll
            for (int b = 0; b < 2; ++b)
#pragma unroll
                for (int m = 0; m < 4; ++m)
#pragma unroll
                    for (int n = 0; n < 2; ++n) acc[a][b][m][n] = (f32x4){0.f, 0.f, 0.f, 0.f};
        cur = nxt; cA = nA; cB = nB; ++ui;
        if constexpr (ALIGN_EPI) { if (wr == 1) PG8_BAR; }
    }
    PG8_WAIT_V(0);
    if constexpr (!ALIGN_EPI) { if (wr == 0) PG8_BAR; }
    PG8_BAR;
    if constexpr (Epi::AFTER_DRAIN) { E.fused(acc, cur, wr, wc, fr, fq, lds, wid, lane); S.done(cur); }
#undef PG8_SA
#undef PG8_SB
#undef PG8_STAGE
#undef PG8_LDA
#undef PG8_LDB
#undef PG8_MMA
#undef PG8_WAIT_V
#undef PG8_WAIT_L
#undef PG8_BAR
#undef PG8_SCHED
}
}
#define LAS __attribute__((address_space(3)))
typedef unsigned short bf16;
typedef unsigned u32x4 __attribute__((ext_vector_type(4)));
typedef unsigned u32x2 __attribute__((ext_vector_type(2)));
typedef float f32x4 __attribute__((ext_vector_type(4)));
typedef float f32x16 __attribute__((ext_vector_type(16)));
typedef short bf16x8 __attribute__((ext_vector_type(8)));
constexpr int NT = 65536, DM = 1024, FF = 2816, SEQ = 2048, NBATCH = 32;
constexpr float RMS_EPS = 1e-6f;
constexpr size_t MiB = 1u << 20;
constexpr size_t WS_TAB = 0;
constexpr size_t WS_WIN = 1 * MiB;
constexpr size_t WS_WOUT = 45 * MiB;
constexpr size_t WS_WGLU = 67 * MiB, WS_WKV = 69 * MiB, WS_WQG = 72 * MiB, WS_WO = 75 * MiB;
constexpr size_t WS_CW1K = 77 * MiB, WS_CW1V = 77 * MiB + 512 * 1024, WS_CW2K = 78 * MiB, WS_CW2V = 78 * MiB + 65536;
constexpr size_t WS_KCMP = 80 * MiB, WS_VCMPT = 82 * MiB;
constexpr size_t WS_XN = 96 * MiB;
constexpr size_t WS_HB = WS_XN;
constexpr size_t WS_RP = 896 * MiB;
constexpr size_t WS_HID = 224 * MiB;
constexpr size_t WS_Q = WS_HID, WS_Z = WS_HID, WS_O = WS_HID + 128 * MiB, WS_GATES = WS_HID + 256 * MiB;
constexpr size_t WS_KV = 576 * MiB;
constexpr size_t WS_KN = 768 * MiB;
constexpr size_t WS_VT = 832 * MiB;
constexpr size_t WS_END = 920 * MiB;
constexpr int LDS_BYTES = 147456;
constexpr int MISC_OFF = 147328;
constexpr size_t WS_BAR = 65536;
constexpr int NPHASE = 14;

__device__ __forceinline__ unsigned f2bf(float f) { unsigned u = __builtin_bit_cast(unsigned, f); return (u + 0x7fffu + ((u >> 16) & 1u)) >> 16; }
typedef float f32x2_t __attribute__((ext_vector_type(2))); typedef __bf16 bf16x2_t __attribute__((ext_vector_type(2)));
__device__ __forceinline__ unsigned pk2(float lo, float hi) { f32x2_t v = {lo, hi}; bf16x2_t b = __builtin_convertvector(v, bf16x2_t); return __builtin_bit_cast(unsigned, b); }
__device__ __forceinline__ float bflo(unsigned w) { return __uint_as_float(w << 16); }
__device__ __forceinline__ float bfhi(unsigned w) { return __uint_as_float(w & 0xffff0000u); }
__device__ __forceinline__ float wave_sum(float v) {
#pragma unroll
    for (int o = 1; o < 64; o <<= 1) v += __shfl_xor(v, o);
    return v;
}
__device__ __forceinline__ float wave_max(float v) {
#pragma unroll
    for (int o = 1; o < 64; o <<= 1) v = fmaxf(v, __shfl_xor(v, o));
    return v;
}
#define LDS_WAIT() asm volatile("s_waitcnt lgkmcnt(0)" ::: "memory")
__device__ __forceinline__ float gelu_tanh(float y) { const float a = 1.5957691216057308f * (y + 0.044715f * y * y * y); return y * __builtin_amdgcn_rcpf(1.0f + __expf(-a)); }
__device__ __forceinline__ int crow(int r, int hi) { return (r & 3) + 8 * (r >> 2) + 4 * hi; }

struct Args { const float* in[32]; float* out; unsigned char* ws; int ph_lo, ph_hi; unsigned char seq[32]; };
typedef const __attribute__((address_space(4))) Args* KArgs;

__device__ __forceinline__ void tr_item(const float* W, int K, int ldn, int nvalid, int mode, bf16* WT, LAS float* scr, int item, int nblk, int lane, const float* gain) {
    const int kb = item / nblk, nb = item % nblk, k0 = 64 * kb, n0 = 64 * nb;
    int sc = n0;
    if (mode) { const int pn = n0 >> 8, rem = n0 & 255, bj = rem >> 7, i = rem & 127; sc = bj * 2816 + 128 * pn + i; }
    const int nq = lane & 15, kr = lane >> 4; const int c = sc + 4 * nq; const bool ok = c < nvalid;
    f32x4 v[16];
#pragma unroll
    for (int i = 0; i < 16; ++i) { const int kk = 4 * i + kr; v[i] = ok ? *(const f32x4*)(W + (size_t)(k0 + kk) * ldn + c) : (f32x4){0.f, 0.f, 0.f, 0.f}; }
#pragma unroll
    for (int i = 0; i < 16; ++i) { const int kk = 4 * i + kr; const float gk = gain ? gain[k0 + kk] : 1.0f; LAS float* d = scr + kk * 65 + 4 * nq;
        d[0] = v[i][0] * gk; d[1] = v[i][1] * gk; d[2] = v[i][2] * gk; d[3] = v[i][3] * gk; }
    LDS_WAIT();
    const int cc = lane & 7;
#pragma unroll
    for (int j = 0; j < 8; ++j) { const int n = (lane >> 3) + 8 * j; const LAS float* p = scr + (8 * cc) * 65 + n;
        u32x4 o; o.x = pk2(p[0 * 65], p[1 * 65]); o.y = pk2(p[2 * 65], p[3 * 65]); o.z = pk2(p[4 * 65], p[5 * 65]); o.w = pk2(p[6 * 65], p[7 * 65]);
        *(u32x4*)(WT + (size_t)(n0 + n) * K + k0 + 8 * cc) = o; }
    LDS_WAIT();
}
__device__ __forceinline__ void x_to_hb(const float* src, bf16* dst, float* rp, int gw, int NGW, int lane) {
    for (int m = gw; m < NT; m += NGW) {
        const f32x4* xr = (const f32x4*)(src + (size_t)m * DM) + lane;
        u32x2 w[4]; float s = 0.f;
#pragma unroll
        for (int j = 0; j < 4; ++j) { const f32x4 v = xr[64 * j]; w[j].x = pk2(v.x, v.y); w[j].y = pk2(v.z, v.w);
            const float q0 = bflo(w[j].x), q1 = bfhi(w[j].x), q2 = bflo(w[j].y), q3 = bfhi(w[j].y); s += (q0 * q0 + q1 * q1) + (q2 * q2 + q3 * q3); }
        s = wave_sum(s);
        u32x2* o8 = (u32x2*)(dst + (size_t)m * DM) + lane;
#pragma unroll
        for (int j = 0; j < 4; ++j) o8[64 * j] = w[j];
        if (lane == 0) *(f32x4*)(rp + (size_t)m * 4) = (f32x4){s, 0.f, 0.f, 0.f};
    }
}
__device__ __forceinline__ int t5_bucket(int d) {
    if (d < 16) return d;
    const float lv = __logf((float)d * (1.0f / 16.0f)) * (1.0f / 2.0794415416798357f);
    int b = 16 + (int)(lv * 16.0f); return b > 31 ? 31 : b;
}
__device__ __forceinline__ void p0_prologue(KArgs ap, LAS unsigned char* lds, int vcu, int G, int wave, int lane, int tid) {
    unsigned char* ws = ap->ws;
    LAS float* scr = (LAS float*)(lds + wave * 16640);
    const int gw = vcu * 8 + wave, NGW = G * 8;
    constexpr int I_IN = 16 * 88, I_OUT = 44 * 16, I_GLU = 16 * 16, I_KV = 16 * 24, I_QG = 16 * 20, I_O = 16 * 16, I_C1 = 32 * 2, I_C2 = 2 * 1;
    constexpr int NITEMS = 4 * I_IN + 4 * I_OUT + I_GLU + I_KV + I_QG + I_O + 2 * I_C1 + 2 * I_C2;
    for (int it = gw; it < NITEMS; it += NGW) {
        int r = it;
        if (r < 4 * I_IN) { const int f = r / I_IN; r -= f * I_IN; const int layer = f >> 1; const float* W = ((f & 1) ? ap->in[7] : ap->in[3]) + (size_t)layer * 1024 * 5632;
            tr_item(W, 1024, 5632, 5632, 1, (bf16*)(ws + WS_WIN + (size_t)f * 11 * MiB), scr, r, 88, lane, ((f & 1) ? ap->in[6] : ap->in[2]) + layer * 1024); continue; } r -= 4 * I_IN;
        if (r < 4 * I_OUT) { const int f = r / I_OUT; r -= f * I_OUT; const int layer = f >> 1; const float* W = ((f & 1) ? ap->in[8] : ap->in[4]) + (size_t)layer * 2816 * 1024;
            tr_item(W, 2816, 1024, 1024, 0, (bf16*)(ws + WS_WOUT + (size_t)f * (11 * MiB / 2)), scr, r, 16, lane, nullptr); continue; } r -= 4 * I_OUT;
        if (r < I_GLU) { tr_item(ap->in[17], 1024, 1024, 1024, 0, (bf16*)(ws + WS_WGLU), scr, r, 16, lane, nullptr); continue; } r -= I_GLU;
        if (r < I_KV) { tr_item(ap->in[19], 1024, 1536, 1536, 0, (bf16*)(ws + WS_WKV), scr, r, 24, lane, ap->in[18]); continue; } r -= I_KV;
        if (r < I_QG) { tr_item(ap->in[29], 1024, 1072, 1072, 0, (bf16*)(ws + WS_WQG), scr, r, 20, lane, ap->in[5] + 1024); continue; } r -= I_QG;
        if (r < I_O) { tr_item(ap->in[31], 1024, 1024, 1024, 0, (bf16*)(ws + WS_WO), scr, r, 16, lane, nullptr); continue; } r -= I_O;
        if (r < I_C1) { tr_item(ap->in[25], 2048, 128, 128, 0, (bf16*)(ws + WS_CW1K), scr, r, 2, lane, nullptr); continue; } r -= I_C1;
        if (r < I_C1) { tr_item(ap->in[27], 2048, 128, 128, 0, (bf16*)(ws + WS_CW1V), scr, r, 2, lane, nullptr); continue; } r -= I_C1;
        if (r < I_C2) { tr_item(ap->in[26], 128, 64, 64, 0, (bf16*)(ws + WS_CW2K), scr, r, 1, lane, nullptr); continue; } r -= I_C2;
        tr_item(ap->in[28], 128, 64, 64, 0, (bf16*)(ws + WS_CW2V), scr, r, 1, lane, nullptr);
    }
    float* tab = (float*)(ws + WS_TAB);
    if (vcu == G - 1) {
        for (int idx = tid; idx < 2048; idx += 512) { const int h = idx >> 7, d = idx & 127; tab[idx] = ap->in[1][t5_bucket(d) * 16 + h]; }
        if (wave == 0) {
            const float mq = wave_max(fabsf(ap->in[30][lane]));
            float mb = 0.f; for (int i = lane; i < 512; i += 64) mb = fmaxf(mb, fabsf(ap->in[1][i])); mb = wave_max(mb);
            const float mc = wave_max(fabsf(ap->in[20][lane])), ms = wave_max(fabsf(ap->in[21][lane])), mw = wave_max(fabsf(ap->in[22][lane]));
            if (lane == 0) { tab[2048] = 8.f * mq * mc + mb; tab[2049] = 8.f * mq * ms + mb; tab[2050] = 8.f * mq * mw + mb; tab[2051] = 0.f; }
        }
    }
    x_to_hb(ap->in[0], (bf16*)(ws + WS_HB), (float*)(ws + WS_RP), gw, NGW, lane);
}
constexpr int S5_KTAB = 0, S5_ABP = 8192, S5_BBC = 16384, S5_UT = 24576, S5_XS = 59392;
__device__ __forceinline__ void s5_phase(KArgs ap, LAS unsigned char* lds, int vcu, int G, int wave, int lane, int tid) {
    unsigned char* ws = ap->ws;
    const bf16* HBp = (const bf16*)(ws + WS_HB); bf16* Z = (bf16*)(ws + WS_Z); const float* rp1 = (const float*)(ws + WS_RP + 1 * 4 * MiB);
    LAS float* KTAB = (LAS float*)(lds + S5_KTAB); LAS float* ABP = (LAS float*)(lds + S5_ABP); LAS float* BBC = (LAS float*)(lds + S5_BBC); LAS float* CC = (LAS float*)(lds + 68096);
    const int fr = lane & 15, fq = lane >> 4;
    for (int item = vcu; item < 128; item += G) {
        const int g = item >> 1, b0 = (item & 1) * 16;
        __syncthreads();
        {
            const int p = tid & 63, part = tid >> 6;
            const float dt = expf(ap->in[11][g]);
            const float are = ap->in[9][g * 64 + p], aim = ap->in[10][g * 64 + p];
            const float mag = expf(are * dt); const float abr = mag * __cosf(aim * dt), abi = mag * __sinf(aim * dt);
            if (part == 0) { float pr = 1.f, pi = 0.f;
                for (int t = 0; t <= 8; ++t) { ABP[(t * 64 + p) * 2] = pr; ABP[(t * 64 + p) * 2 + 1] = pi; const float nr = pr * abr - pi * abi, ni = pr * abi + pi * abr; pr = nr; pi = ni; } }
            const float den = are * are + aim * aim;
            const float zr = ((abr - 1.0f) * are + abi * aim) / den, zi = (abi * are - (abr - 1.0f) * aim) / den;
#pragma unroll
            for (int e = 0; e < 2; ++e) { const int h = 2 * part + e; const float br = ap->in[12][(size_t)(g * 64 + p) * 16 + h], bi = ap->in[13][(size_t)(g * 64 + p) * 16 + h]; const float gn = ap->in[5][g * 16 + h];
                BBC[(p * 16 + h) * 2] = (zr * br - zi * bi) * gn; BBC[(p * 16 + h) * 2 + 1] = (zr * bi + zi * br) * gn; }
            for (int i = tid; i < 1024; i += 512) { CC[2 * i] = ap->in[14][(size_t)g * 1024 + i]; CC[2 * i + 1] = ap->in[15][(size_t)g * 1024 + i]; }
        }
        __syncthreads();
        {
            const int hp = tid & 15, h = (tid >> 4) & 15, tau0 = (tid >> 8) * 4;
            float acc[4] = {0.f, 0.f, 0.f, 0.f};
            for (int p = 0; p < 64; ++p) {
                const float cr = CC[(hp * 64 + p) * 2], ci = CC[(hp * 64 + p) * 2 + 1], br = BBC[(p * 16 + h) * 2], bi = BBC[(p * 16 + h) * 2 + 1];
                const float wr = cr * br - ci * bi, wi = cr * bi + ci * br;
#pragma unroll
                for (int e = 0; e < 4; ++e) { const float ar = ABP[((tau0 + e) * 64 + p) * 2], ai = ABP[((tau0 + e) * 64 + p) * 2 + 1]; acc[e] += wr * ar - wi * ai; }
            }
            if (tau0 == 0 && h == hp) acc[0] += ap->in[16][g * 16 + h] * ap->in[5][g * 16 + h];
#pragma unroll
            for (int e = 0; e < 4; ++e) KTAB[(tau0 + e) * 256 + h * 16 + hp] = acc[e];
        }
        __syncthreads();
        bf16x8 BY[4], BC[4], BX[4];
        const int t = wave;
#pragma unroll
        for (int ks = 0; ks < 4; ++ks) { const int sx = 2 * ks + (fq >> 1); float v[8];
#pragma unroll
            for (int j = 0; j < 8; ++j) { const int h = (fq & 1) * 8 + j; v[j] = (t >= sx) ? KTAB[((t - sx) * 16 + h) * 16 + fr] : 0.f; }
            u32x4 w; w.x = pk2(v[0], v[1]); w.y = pk2(v[2], v[3]); w.z = pk2(v[4], v[5]); w.w = pk2(v[6], v[7]); BY[ks] = __builtin_bit_cast(bf16x8, w); }
#pragma unroll
        for (int ks = 0; ks < 4; ++ks) { float v[8];
#pragma unroll
            for (int jj = 0; jj < 4; ++jj) { const int p = 16 * ks + 4 * fq + jj; const float cr = CC[(fr * 64 + p) * 2], ci = CC[(fr * 64 + p) * 2 + 1];
                const float ar = ABP[((t + 1) * 64 + p) * 2], ai = ABP[((t + 1) * 64 + p) * 2 + 1]; v[2 * jj] = cr * ar - ci * ai; v[2 * jj + 1] = -(cr * ai + ci * ar); }
            u32x4 w; w.x = pk2(v[0], v[1]); w.y = pk2(v[2], v[3]); w.z = pk2(v[4], v[5]); w.w = pk2(v[6], v[7]); BC[ks] = __builtin_bit_cast(bf16x8, w); }
        const int cidx = 16 * wave + fr, xp = cidx >> 1, xcomp = cidx & 1;
#pragma unroll
        for (int ks = 0; ks < 4; ++ks) { const int sx = 2 * ks + (fq >> 1); float v[8];
            const float ar = ABP[((7 - sx) * 64 + xp) * 2], ai = ABP[((7 - sx) * 64 + xp) * 2 + 1];
#pragma unroll
            for (int j = 0; j < 8; ++j) { const int h = (fq & 1) * 8 + j; const float br = BBC[(xp * 16 + h) * 2], bi = BBC[(xp * 16 + h) * 2 + 1]; v[j] = xcomp ? (ar * bi + ai * br) : (ar * br - ai * bi); }
            u32x4 w; w.x = pk2(v[0], v[1]); w.y = pk2(v[2], v[3]); w.z = pk2(v[4], v[5]); w.w = pk2(v[6], v[7]); BX[ks] = __builtin_bit_cast(bf16x8, w); }
        const float a8r = ABP[(8 * 64 + xp) * 2], a8i = ABP[(8 * 64 + xp) * 2 + 1] * (xcomp ? 1.f : -1.f);
        LAS unsigned char* UT = lds + S5_UT; LAS unsigned char* XS = lds + S5_XS;
        for (int i = tid; i < 16 * 136 / 2; i += 512) ((LAS unsigned*)XS)[i] = 0u;
        f32x4 rot = {0.f, 0.f, 0.f, 0.f};
        const bf16* up[2]; const float* rpp[2]; int uoff[2];
#pragma unroll
        for (int e = 0; e < 2; ++e) { const int q = tid + 512 * e, tl = q >> 8, sbb = (q >> 4) & 15, stk = (q & 15) >> 1, h8 = q & 1;
            up[e] = HBp + (size_t)((b0 + sbb) * SEQ + tl * 8 + stk) * DM + g * 16 + h8 * 8; rpp[e] = rp1 + (size_t)((b0 + sbb) * SEQ + tl * 8 + stk) * 4;
            uoff[e] = tl * 4352 + sbb * 272 + (stk * 16 + h8 * 8) * 2; }
        u32x4 pre[2]; f32x4 prs4[2];
#pragma unroll
        for (int e = 0; e < 2; ++e) { pre[e] = *(const u32x4*)up[e]; prs4[e] = *(const f32x4*)rpp[e]; }
        for (int st = 0; st < 64; ++st) {
            LAS unsigned char* UTs = UT + (st & 1) * 17408;
#pragma unroll
            for (int e = 0; e < 2; ++e) { const float rs = __builtin_amdgcn_rsqf(((prs4[e][0] + prs4[e][1]) + (prs4[e][2] + prs4[e][3])) * (1.0f / 1024.0f) + RMS_EPS);
                u32x4 w; w.x = pk2(bflo(pre[e].x) * rs, bfhi(pre[e].x) * rs); w.y = pk2(bflo(pre[e].y) * rs, bfhi(pre[e].y) * rs); w.z = pk2(bflo(pre[e].z) * rs, bfhi(pre[e].z) * rs); w.w = pk2(bflo(pre[e].w) * rs, bfhi(pre[e].w) * rs);
                *(LAS u32x4*)(UTs + uoff[e]) = w; }
#pragma unroll 1
            for (int tl = 0; tl < 4; ++tl) {
                const int tile = st * 4 + tl, buf = tile & 1;
                asm volatile("s_waitcnt lgkmcnt(0)" ::: "memory"); __builtin_amdgcn_s_barrier(); asm volatile("" ::: "memory");
                if (tl == 0 && st + 1 < 64) {
#pragma unroll
                    for (int e = 0; e < 2; ++e) { pre[e] = *(const u32x4*)(up[e] + (size_t)(st + 1) * 32 * DM); prs4[e] = *(const f32x4*)(rpp[e] + (size_t)(st + 1) * 32 * 4); } }
                bf16x8 au[4];
#pragma unroll
                for (int ks = 0; ks < 4; ++ks) au[ks] = *(const LAS bf16x8*)(UTs + tl * 4352 + fr * 272 + (32 * ks + 8 * fq) * 2);
                f32x4 nxa = rot, nxb = {0.f, 0.f, 0.f, 0.f};
                nxa = __builtin_amdgcn_mfma_f32_16x16x32_bf16(au[0], BX[0], nxa, 0, 0, 0);
                nxb = __builtin_amdgcn_mfma_f32_16x16x32_bf16(au[2], BX[2], nxb, 0, 0, 0);
                nxa = __builtin_amdgcn_mfma_f32_16x16x32_bf16(au[1], BX[1], nxa, 0, 0, 0);
                nxb = __builtin_amdgcn_mfma_f32_16x16x32_bf16(au[3], BX[3], nxb, 0, 0, 0);
                const f32x4 nx = nxa + nxb;
#pragma unroll
                for (int j = 0; j < 4; ++j) *(LAS bf16*)(XS + (buf ^ 1) * 4352 + (4 * fq + j) * 272 + cidx * 2) = (bf16)(pk2(nx[j], 0.f) & 0xffffu);
                __builtin_amdgcn_sched_barrier(0);
                { const f32x4 oth = {__shfl_xor(nx[0], 1), __shfl_xor(nx[1], 1), __shfl_xor(nx[2], 1), __shfl_xor(nx[3], 1)};
                  rot = nx * a8r + oth * a8i; }
                f32x4 acc0 = {0.f, 0.f, 0.f, 0.f}, acc1 = {0.f, 0.f, 0.f, 0.f};
#pragma unroll
                for (int ks = 0; ks < 4; ++ks) acc0 = __builtin_amdgcn_mfma_f32_16x16x32_bf16(au[ks], BY[ks], acc0, 0, 0, 0);
#pragma unroll
                for (int ks = 0; ks < 4; ++ks) { const bf16x8 a = *(const LAS bf16x8*)(XS + buf * 4352 + fr * 272 + (32 * ks + 8 * fq) * 2);
                    acc1 = __builtin_amdgcn_mfma_f32_16x16x32_bf16(a, BC[ks], acc1, 0, 0, 0); }
                const int tok = tile * 8 + wave;
#pragma unroll
                for (int j = 0; j < 4; ++j) Z[(size_t)((b0 + 4 * fq + j) * SEQ + tok) * DM + g * 16 + fr] = (bf16)(pk2(gelu_tanh(acc0[j] + acc1[j]), 0.f) & 0xffffu);
            }
        }
    }
}

__device__ __forceinline__ void kvpost_phase(KArgs ap, LAS unsigned char* lds, int gw, int NGW, int wave, int lane) {
    unsigned char* ws = ap->ws;
    const bf16* KV = (const bf16*)(ws + WS_KV); bf16* KN = (bf16*)(ws + WS_KN); bf16* VT = (bf16*)(ws + WS_VT);
    LAS bf16* Vs = (LAS bf16*)(lds + wave * 8704);
    const int ch = lane & 7, tr = lane >> 3;
    for (int item = gw; item < 8192; item += NGW) {
        const int tt = item & 31, g = (item >> 5) & 3, b = (item >> 7) & 31, which = item >> 12;
        const float* gain = which ? ap->in[22] : ap->in[21];
        const f32x4 g0 = *(const f32x4*)(gain + ch * 8), g1 = *(const f32x4*)(gain + ch * 8 + 4);
        const bf16* src = KV + ((size_t)((2 + 2 * which) * 4 + g) * NT + b * SEQ + tt * 64) * 64;
        bf16* kdst = KN + ((size_t)((which * 32 + b) * 4 + g) * SEQ + tt * 64) * 64;
        bf16* vdst = VT + (size_t)((which * 32 + b) * 4 + g) * 64 * SEQ + tt * 64;
#pragma unroll
        for (int i = 0; i < 8; ++i) {
            const int tok = i * 8 + tr;
            const u32x4 kr = *(const u32x4*)(src + (size_t)tok * 64 + ch * 8);
            const u32x4 vr = *(const u32x4*)(src + (size_t)4 * NT * 64 + (size_t)tok * 64 + ch * 8);
            float x[8] = {bflo(kr.x), bfhi(kr.x), bflo(kr.y), bfhi(kr.y), bflo(kr.z), bfhi(kr.z), bflo(kr.w), bfhi(kr.w)};
            float ss = 0.f;
#pragma unroll
            for (int e = 0; e < 8; ++e) ss += x[e] * x[e];
            ss += __shfl_xor(ss, 1); ss += __shfl_xor(ss, 2); ss += __shfl_xor(ss, 4);
            const float rs = rsqrtf(ss * (1.f / 64.f) + RMS_EPS);
            u32x4 o; o.x = pk2(x[0] * rs * g0[0], x[1] * rs * g0[1]); o.y = pk2(x[2] * rs * g0[2], x[3] * rs * g0[3]); o.z = pk2(x[4] * rs * g1[0], x[5] * rs * g1[1]); o.w = pk2(x[6] * rs * g1[2], x[7] * rs * g1[3]);
            *(u32x4*)(kdst + (size_t)tok * 64 + ch * 8) = o;
            LAS unsigned* vw = (LAS unsigned*)(Vs + tok * 66 + ch * 8); vw[0] = vr.x; vw[1] = vr.y; vw[2] = vr.z; vw[3] = vr.w;
        }
        LDS_WAIT();
#pragma unroll
        for (int i = 0; i < 8; ++i) {
            const int d = i * 8 + tr;
            unsigned e[8];
#pragma unroll
            for (int q = 0; q < 8; ++q) e[q] = Vs[(ch * 8 + q) * 66 + d];
            u32x4 o; o.x = e[0] | (e[1] << 16); o.y = e[2] | (e[3] << 16); o.z = e[4] | (e[5] << 16); o.w = e[6] | (e[7] << 16);
            *(u32x4*)(vdst + (size_t)d * SEQ + ch * 8) = o;
        }
        LDS_WAIT();
    }
}

__device__ __forceinline__ void compress_phase(KArgs ap, LAS unsigned char* lds, int vcu, int G, int wave, int lane) {
    unsigned char* ws = ap->ws;
    const bf16* KV = (const bf16*)(ws + WS_KV);
    const float* tab = (const float*)(ws + WS_TAB);
    const int fr = lane & 15, fq = lane >> 4;
    LAS bf16* Hs = (LAS bf16*)(lds + 73728 + wave * 4352);
    for (int unit = vcu; unit < 256; unit += G) {
        const int kv = unit >> 7, b = (unit >> 2) & 31, g = unit & 3;
        const bf16* W1 = (const bf16*)(ws + (kv ? WS_CW1V : WS_CW1K)); const bf16* W2 = (const bf16*)(ws + (kv ? WS_CW2V : WS_CW2K));
        const int c0 = wave * 16;
        const float* posp = kv ? ap->in[24] : ap->in[23];
        const bf16* abase = KV + ((size_t)(kv * 4 + g) * NT + b * SEQ) * 64 + fq * 8;
        const int tokb = 16 * (c0 + fr);
        f32x4 acc[8];
#pragma unroll
        for (int n = 0; n < 8; ++n) acc[n] = (f32x4){0.f, 0.f, 0.f, 0.f};
#define CMP_LOAD(AR, P0, P1, BV, KS) do { int tok_ = tokb + ((KS) >> 1); tok_ = tok_ > SEQ - 1 ? SEQ - 1 : tok_; \
            AR = *(const u32x4*)(abase + (size_t)tok_ * 64 + ((KS) & 1) * 32); \
            const float* pp_ = posp + ((KS) >> 1) * 64 + ((KS) & 1) * 32 + fq * 8; P0 = *(const f32x4*)pp_; P1 = *(const f32x4*)(pp_ + 4); \
            _Pragma("unroll") for (int n = 0; n < 8; ++n) BV[n] = *(const bf16x8*)(W1 + (size_t)(n * 16 + fr) * 2048 + (KS) * 32 + fq * 8); } while (0)
#define CMP_MMA(AR, P0, P1, BV) do { u32x4 aw_; aw_.x = pk2(bflo(AR.x) + P0[0], bfhi(AR.x) + P0[1]); aw_.y = pk2(bflo(AR.y) + P0[2], bfhi(AR.y) + P0[3]); \
            aw_.z = pk2(bflo(AR.z) + P1[0], bfhi(AR.z) + P1[1]); aw_.w = pk2(bflo(AR.w) + P1[2], bfhi(AR.w) + P1[3]); const bf16x8 av_ = __builtin_bit_cast(bf16x8, aw_); \
            _Pragma("unroll") for (int n = 0; n < 8; ++n) acc[n] = __builtin_amdgcn_mfma_f32_16x16x32_bf16(av_, BV[n], acc[n], 0, 0, 0); } while (0)
        {
            u32x4 arA, arB; f32x4 pA0, pA1, pB0, pB1; bf16x8 bvA[8], bvB[8];
            CMP_LOAD(arA, pA0, pA1, bvA, 0);
#pragma unroll 1
            for (int ks = 0; ks < 64; ks += 2) {
                CMP_LOAD(arB, pB0, pB1, bvB, ks + 1);
                __builtin_amdgcn_sched_barrier(0);
                CMP_MMA(arA, pA0, pA1, bvA);
                __builtin_amdgcn_sched_barrier(0);
                if (ks + 2 < 64) CMP_LOAD(arA, pA0, pA1, bvA, ks + 2);
                __builtin_amdgcn_sched_barrier(0);
                CMP_MMA(arB, pB0, pB1, bvB);
                __builtin_amdgcn_sched_barrier(0);
            }
        }
#undef CMP_LOAD
#undef CMP_MMA
#pragma unroll
        for (int n = 0; n < 8; ++n) { const float pb = 0.f;
#pragma unroll
            for (int j = 0; j < 4; ++j) Hs[(4 * fq + j) * 136 + n * 16 + fr] = (bf16)f2bf(gelu_tanh(acc[n][j] + pb)); }
        LDS_WAIT();
        bf16x8 ha[4];
#pragma unroll
        for (int ks = 0; ks < 4; ++ks) ha[ks] = *(const LAS bf16x8*)(Hs + fr * 136 + 32 * ks + 8 * fq);
        f32x4 o2[4];
#pragma unroll
        for (int n = 0; n < 4; ++n) { o2[n] = (f32x4){0.f, 0.f, 0.f, 0.f};
#pragma unroll
            for (int ks = 0; ks < 4; ++ks) { const bf16x8 bv = *(const bf16x8*)(W2 + (size_t)(n * 16 + fr) * 128 + ks * 32 + fq * 8); o2[n] = __builtin_amdgcn_mfma_f32_16x16x32_bf16(ha[ks], bv, o2[n], 0, 0, 0); } }
        LDS_WAIT();
        if (kv == 0) {
            bf16* dst = (bf16*)(ws + WS_KCMP) + (size_t)((b * 4 + g) * 128) * 64;
#pragma unroll
            for (int j = 0; j < 4; ++j) { float ss = 0.f;
#pragma unroll
                for (int n = 0; n < 4; ++n) ss += o2[n][j] * o2[n][j];
                ss += __shfl_xor(ss, 1); ss += __shfl_xor(ss, 2); ss += __shfl_xor(ss, 4); ss += __shfl_xor(ss, 8);
                const float rs = rsqrtf(ss * (1.f / 64.f) + RMS_EPS); const int c = c0 + 4 * fq + j;
#pragma unroll
                for (int n = 0; n < 4; ++n) { const float v = (c < 127) ? o2[n][j] * rs * ap->in[20][n * 16 + fr] : 0.f; dst[(size_t)c * 64 + n * 16 + fr] = (bf16)f2bf(v); } }
        } else {
            bf16* dst = (bf16*)(ws + WS_VCMPT) + (size_t)((b * 4 + g) * 64) * 128;
#pragma unroll
            for (int n = 0; n < 4; ++n) { const int c = c0 + 4 * fq; float v[4];
#pragma unroll
                for (int j = 0; j < 4; ++j) v[j] = (c + j < 127) ? o2[n][j] : 0.f;
                u32x2 w; w.x = pk2(v[0], v[1]); w.y = pk2(v[2], v[3]); *(u32x2*)(dst + (size_t)(n * 16 + fr) * 128 + c) = w; }
        }
    }
}
constexpr int AT_KT = 0, AT_VT = 36864, AT_PSL = 0, AT_BIAS = 71680, AT_SEL = 73728, AT_TOT = 73984, AT_STRIDE = 144;
constexpr float LOG2E = 1.4426950408889634f;
#define MFMA32(a, b, c) __builtin_amdgcn_mfma_f32_32x32x16_bf16((a), (b), (c), 0, 0, 0)
__device__ __forceinline__ bf16x8 pack8(const f32x16& s, int s2) {
    u32x4 w; w.x = pk2(s[8 * s2 + 0], s[8 * s2 + 1]); w.y = pk2(s[8 * s2 + 2], s[8 * s2 + 3]); w.z = pk2(s[8 * s2 + 4], s[8 * s2 + 5]); w.w = pk2(s[8 * s2 + 6], s[8 * s2 + 7]);
    return __builtin_bit_cast(bf16x8, w);
}
template <int MODE>
__device__ __forceinline__ void attn_first_load(const bf16* Kg, const bf16* Vg, int qt, int tid, u32x4 (&kreg)[2], u32x4 (&vreg)[2]) {
    const int kb_lo = MODE == 0 ? 0 : (qt > 8 ? qt - 8 : 0), kb_hi = qt;
    const int kb0 = kb_lo - ((kb_hi - kb_lo + 1) & 1);
    const int krow = tid >> 2, kch = tid & 3, vrow = tid >> 3, vch = tid & 7;
    const bf16* kp = Kg + (size_t)(krow & 63) * 64 + kch * 16; const int ksub = krow >> 6;
    const bf16* vp = Vg + (size_t)vrow * SEQ + (vch & 3) * 16; const int vsub = vch >> 2;
    const int kbk = (kb0 + ksub) < kb_lo ? kb_lo : (kb0 + ksub), kbv = (kb0 + vsub) < kb_lo ? kb_lo : (kb0 + vsub);
    kreg[0] = *(const u32x4*)(kp + (size_t)kbk * 4096); kreg[1] = *(const u32x4*)(kp + (size_t)kbk * 4096 + 8);
    vreg[0] = *(const u32x4*)(vp + kbv * 64); vreg[1] = *(const u32x4*)(vp + kbv * 64 + 8);
}
template <int MODE>
__device__ __forceinline__ void attn_loop(LAS unsigned char* lds, const bf16* Kg, const bf16* Vg, int qt, int tq, unsigned selm, const bf16x8 (&qf)[4], const LAS float* biasr, float nshift,
                                          f32x16 (&o)[2], float& lsum, int tid, int ql, int hi, u32x4 (&kreg)[2], u32x4 (&vreg)[2]) {
    const int kb_lo = MODE == 0 ? 0 : (qt > 8 ? qt - 8 : 0), kb_hi = qt;
    const int kb0 = kb_lo - ((kb_hi - kb_lo + 1) & 1);
    const int krow = tid >> 2, kch = tid & 3, vrow = tid >> 3, vch = tid & 7;
    const bf16* kp = Kg + (size_t)(krow & 63) * 64 + kch * 16; const int ksub = krow >> 6;
    const bf16* vp = Vg + (size_t)vrow * SEQ + (vch & 3) * 16; const int vsub = vch >> 2;
#pragma unroll
    for (int i = 0; i < 16; ++i) { o[0][i] = 0.f; o[1][i] = 0.f; }
    float l = 0.f;
    const float bfar = biasr[127];
    int it = 0;
    for (int kb = kb0; kb < kb_hi; kb += 2, ++it) {
        const int buf = it & 1;
        LAS unsigned char* KT = lds + AT_KT + buf * 18432; LAS unsigned char* VT = lds + AT_VT + buf * 17408;
        *(LAS u32x4*)(KT + krow * AT_STRIDE + kch * 32) = kreg[0]; *(LAS u32x4*)(KT + krow * AT_STRIDE + kch * 32 + 16) = kreg[1];
        *(LAS u32x4*)(VT + vrow * 272 + vch * 32) = vreg[0]; *(LAS u32x4*)(VT + vrow * 272 + vch * 32 + 16) = vreg[1];
        __syncthreads();
        if (kb + 2 < kb_hi) { const int kbk = kb + 2 + ksub, kbv = kb + 2 + vsub;
            kreg[0] = *(const u32x4*)(kp + (size_t)kbk * 4096); kreg[1] = *(const u32x4*)(kp + (size_t)kbk * 4096 + 8);
            vreg[0] = *(const u32x4*)(vp + kbv * 64); vreg[1] = *(const u32x4*)(vp + kbv * 64 + 8); }
#pragma unroll
        for (int sb = 0; sb < 2; ++sb) {
            const int kbb = kb + sb;
            if (kbb < kb_lo) continue;
            f32x16 s[2];
            bf16x8 kf[8];
#pragma unroll
            for (int kt = 0; kt < 2; ++kt)
#pragma unroll
                for (int ks = 0; ks < 4; ++ks) kf[kt * 4 + ks] = *(const LAS bf16x8*)(KT + (64 * sb + 32 * kt + ql) * AT_STRIDE + (16 * ks + 8 * hi) * 2);
            const bool bsel = (kbb >= kb_lo) && (MODE == 1 || ((selm >> (kbb & 31)) & 1u) != 0u);
            const int delta = qt - kbb;
            const bool interior = delta >= 3 && (MODE == 0 || delta <= 7);
            const bool edge = MODE == 1 && delta >= 3 && !interior;
            const float sinit = interior ? (nshift + (bsel ? bfar : -INFINITY)) : (edge ? nshift + bfar : nshift);
            __builtin_amdgcn_sched_barrier(0);
#pragma unroll
            for (int kt = 0; kt < 2; ++kt)
#pragma unroll
                for (int i = 0; i < 16; ++i) s[kt][i] = sinit;
            __builtin_amdgcn_s_setprio(1);
#pragma unroll
            for (int kt = 0; kt < 2; ++kt)
#pragma unroll
                for (int ks = 0; ks < 4; ++ks) s[kt] = MFMA32(kf[kt * 4 + ks], qf[ks], s[kt]);
            __builtin_amdgcn_s_setprio(0);
            if (interior) {
#pragma unroll
                for (int kt = 0; kt < 2; ++kt)
#pragma unroll
                    for (int i = 0; i < 16; ++i) { const float pv = __builtin_amdgcn_exp2f(s[kt][i]); s[kt][i] = pv; l += pv; }
            } else if (edge) {
                const int D0 = tq - kbb * 64 - 4 * hi;
#pragma unroll
                for (int kt = 0; kt < 2; ++kt)
#pragma unroll
                    for (int i = 0; i < 16; ++i) {
                        const int dist = D0 - (32 * kt + (i & 3) + 8 * (i >> 2));
                        const float pv = dist < 512 ? __builtin_amdgcn_exp2f(s[kt][i]) : 0.f;
                        s[kt][i] = pv; l += pv;
                    }
            } else {
                const int D0 = tq - kbb * 64 - 4 * hi;
#pragma unroll
                for (int kt = 0; kt < 2; ++kt)
#pragma unroll
                    for (int i = 0; i < 16; ++i) {
                        const int dist = D0 - (32 * kt + (i & 3) + 8 * (i >> 2));
                        bool valid = bsel && dist >= 0; if (MODE == 1) valid = valid && dist < 512;
                        const int di = dist < 0 ? 0 : (dist > 127 ? 127 : dist);
                        const float pv = valid ? __builtin_amdgcn_exp2f(s[kt][i] + biasr[di]) : 0.f;
                        s[kt][i] = pv; l += pv;
                    }
            }
#pragma unroll
            for (int kt = 0; kt < 2; ++kt) {
                u32x2 vlo[4], vhi[4];
#pragma unroll
                for (int s2 = 0; s2 < 2; ++s2)
#pragma unroll
                    for (int mt = 0; mt < 2; ++mt) { const LAS unsigned char* vb = VT + (32 * mt + ql) * 272 + (64 * sb + 32 * kt + 16 * s2 + 4 * hi) * 2;
                        vlo[s2 * 2 + mt] = *(const LAS u32x2*)vb; vhi[s2 * 2 + mt] = *(const LAS u32x2*)(vb + 16); }
                const bf16x8 pb0 = pack8(s[kt], 0), pb1 = pack8(s[kt], 1);
                __builtin_amdgcn_sched_barrier(0);
                __builtin_amdgcn_s_setprio(1);
#pragma unroll
                for (int s2 = 0; s2 < 2; ++s2)
#pragma unroll
                    for (int mt = 0; mt < 2; ++mt) {
                        const u32x2 lo = vlo[s2 * 2 + mt], hi2 = vhi[s2 * 2 + mt];
                        u32x4 w; w.x = lo.x; w.y = lo.y; w.z = hi2.x; w.w = hi2.y;
                        o[mt] = MFMA32(__builtin_bit_cast(bf16x8, w), s2 ? pb1 : pb0, o[mt]);
                    }
                __builtin_amdgcn_s_setprio(0);
            }
        }
    }
    l += __shfl_xor(l, 32);
    lsum = l;
    __syncthreads();
}

__device__ __forceinline__ void attn_phase(KArgs ap, LAS unsigned char* lds, int vcu, int G, int wave, int lane, int tid) {
    const int r = wave >> 1, th = wave & 1, ql = lane & 31, hi = lane >> 5;
    LAS float* PSL = (LAS float*)(lds + AT_PSL); LAS float* BIAS = (LAS float*)(lds + AT_BIAS); LAS unsigned* SEL = (LAS unsigned*)(lds + AT_SEL);
#define ATT_QLOAD(U) do { const int bg_ = ((U) & 255) >> 1, par_ = (U) & 1, ii_ = (U) >> 8, k2_ = ii_ >> 1; const int qt_ = (ii_ & 1) ? (31 - 2 * k2_ - par_) : (2 * k2_ + par_); \
        const int b_ = bg_ >> 2, h_ = (bg_ & 3) * 4 + r; const size_t row_ = (size_t)(b_ * SEQ + qt_ * 64 + th * 32 + ql); \
        const bf16* qp_ = (const bf16*)(ap->ws + WS_Q) + row_ * DM + h_ * 64 + 8 * hi; \
        _Pragma("unroll") for (int ks = 0; ks < 4; ++ks) qraw[ks] = *(const u32x4*)(qp_ + 16 * ks); \
        const float* gp_ = (const float*)(ap->ws + WS_GATES) + row_ * 48 + h_ * 3; gtn0 = gp_[0]; gtn1 = gp_[1]; gtn2 = gp_[2]; } while (0)
    u32x4 qraw[4]; float gtn0 = 0.f, gtn1 = 0.f, gtn2 = 0.f;
    if (vcu < 4096) ATT_QLOAD(vcu);
    for (int u = vcu; u < 4096; u += G) {
        asm volatile("" : "+s"(ap));
        unsigned char* ws = ap->ws;
        const float* tab = (const float*)(ws + WS_TAB);
        const bf16* Qb = (const bf16*)(ws + WS_Q); const float* gatesb = (const float*)(ws + WS_GATES); bf16* Ob = (bf16*)(ws + WS_O);
        const bf16* KN = (const bf16*)(ws + WS_KN); const bf16* VTg = (const bf16*)(ws + WS_VT);
        const bf16* KC = (const bf16*)(ws + WS_KCMP); const bf16* VC = (const bf16*)(ws + WS_VCMPT);
        const float sh_cmp = -tab[2048] * LOG2E, sh_slc = -tab[2049] * LOG2E, sh_win = -tab[2050] * LOG2E;
        const int bg = (u & 255) >> 1, par = u & 1, ii = u >> 8, k2 = ii >> 1;
        const int qt = (ii & 1) ? (31 - 2 * k2 - par) : (2 * k2 + par);
        const int b = bg >> 2, g = bg & 3, h = g * 4 + r;
        const int tq = qt * 64 + th * 32 + ql;
        BIAS[tid] = tab[g * 512 + tid] * LOG2E;
        bf16x8 qf[4];
        {
            u32x4 raw[4]; float ss = 0.f;
#pragma unroll
            for (int ks = 0; ks < 4; ++ks) { raw[ks] = qraw[ks];
                const float x0 = bflo(raw[ks].x), x1 = bfhi(raw[ks].x), x2 = bflo(raw[ks].y), x3 = bfhi(raw[ks].y), x4 = bflo(raw[ks].z), x5 = bfhi(raw[ks].z), x6 = bflo(raw[ks].w), x7 = bfhi(raw[ks].w);
                ss += (x0 * x0 + x1 * x1) + (x2 * x2 + x3 * x3) + (x4 * x4 + x5 * x5) + (x6 * x6 + x7 * x7); }
            ss += __shfl_xor(ss, 32);
            const float rs = rsqrtf(ss * (1.f / 64.f) + RMS_EPS) * (0.125f * LOG2E);
#pragma unroll
            for (int ks = 0; ks < 4; ++ks) { const f32x4 g0 = *(const f32x4*)(ap->in[30] + 16 * ks + 8 * hi), g1 = *(const f32x4*)(ap->in[30] + 16 * ks + 8 * hi + 4);
                u32x4 w; w.x = pk2(bflo(raw[ks].x) * rs * g0[0], bfhi(raw[ks].x) * rs * g0[1]); w.y = pk2(bflo(raw[ks].y) * rs * g0[2], bfhi(raw[ks].y) * rs * g0[3]);
                w.z = pk2(bflo(raw[ks].z) * rs * g1[0], bfhi(raw[ks].z) * rs * g1[1]); w.w = pk2(bflo(raw[ks].w) * rs * g1[2], bfhi(raw[ks].w) * rs * g1[3]);
                qf[ks] = __builtin_bit_cast(bf16x8, w); }
        }
        const float gt0 = gtn0, gt1 = gtn1, gt2 = gtn2;
        __syncthreads();
        const LAS float* biasr = BIAS + r * 128;
        LAS float* TOT = (LAS float*)(lds + AT_TOT) + wave * 2048 + lane;
        {
            f32x16 s[4];
            const bf16* kc = KC + (size_t)(bg * 128) * 64;
            {
#pragma unroll
                for (int kh = 0; kh < 2; ++kh) {
                    bf16x8 kf[8];
#pragma unroll
                    for (int k2 = 0; k2 < 2; ++k2)
#pragma unroll
                        for (int ks = 0; ks < 4; ++ks) kf[k2 * 4 + ks] = *(const bf16x8*)(kc + (size_t)(32 * (2 * kh + k2) + ql) * 64 + 16 * ks + 8 * hi);
                    __builtin_amdgcn_sched_barrier(0);
#pragma unroll
                    for (int k2 = 0; k2 < 2; ++k2) {
#pragma unroll
                        for (int i = 0; i < 16; ++i) s[2 * kh + k2][i] = sh_cmp;
#pragma unroll
                        for (int ks = 0; ks < 4; ++ks) s[2 * kh + k2] = MFMA32(kf[k2 * 4 + ks], qf[ks], s[2 * kh + k2]);
                    }
                }
            }
            float l = 0.f;
            const int D0 = tq - 31 - 64 * hi;
#pragma unroll
            for (int kt = 0; kt < 4; ++kt)
#pragma unroll
                for (int i = 0; i < 16; ++i) {
                    const int dist = D0 - 16 * (32 * kt + (i & 3) + 8 * (i >> 2));
                    const bool valid = dist >= 0;
                    const int di = dist < 0 ? 0 : (dist > 127 ? 127 : dist);
                    const float pv = valid ? __builtin_amdgcn_exp2f(s[kt][i] + biasr[di]) : 0.f;
                    s[kt][i] = pv; l += pv;
                }
            l += __shfl_xor(l, 32);
            const float inv = l > 0.f ? 1.0f / l : 0.f;
            {
                LAS float* pslr = PSL + (r * 64 + th * 32 + ql) * 36;
                float prev = 0.f;
#pragma unroll
                for (int m = 0; m < 16; ++m) {
                    const int kt = m >> 2, i0 = 4 * (m & 3);
                    const float half3 = 0.5f * s[kt][i0 + 3];
                    const float own = (s[kt][i0] + s[kt][i0 + 1]) + (s[kt][i0 + 2] + half3);
                    const float other = __shfl_xor(half3, 32);
                    const float add = hi ? other : prev;
                    prev = other;
                    pslr[2 * m + hi] = (own + add) * inv;
                }
            }
            f32x16 o[2];
#pragma unroll
            for (int i = 0; i < 16; ++i) { o[0][i] = 0.f; o[1][i] = 0.f; }
            const bf16* vc = VC + (size_t)(bg * 64) * 128;
#pragma unroll
            for (int kh = 0; kh < 2; ++kh) {
                u32x2 vlo[8], vhi[8];
#pragma unroll
                for (int k2 = 0; k2 < 2; ++k2)
#pragma unroll
                    for (int s2 = 0; s2 < 2; ++s2)
#pragma unroll
                        for (int mt = 0; mt < 2; ++mt) { const bf16* vb = vc + (size_t)(32 * mt + ql) * 128 + 32 * (2 * kh + k2) + 16 * s2 + 4 * hi;
                            vlo[(k2 * 2 + s2) * 2 + mt] = *(const u32x2*)vb; vhi[(k2 * 2 + s2) * 2 + mt] = *(const u32x2*)(vb + 8); }
                __builtin_amdgcn_sched_barrier(0);
#pragma unroll
                for (int k2 = 0; k2 < 2; ++k2)
#pragma unroll
                    for (int s2 = 0; s2 < 2; ++s2) {
                        const bf16x8 pb = pack8(s[2 * kh + k2], s2);
#pragma unroll
                        for (int mt = 0; mt < 2; ++mt) {
                            const u32x2 lo = vlo[(k2 * 2 + s2) * 2 + mt], hi2 = vhi[(k2 * 2 + s2) * 2 + mt];
                            u32x4 w; w.x = lo.x; w.y = lo.y; w.z = hi2.x; w.w = hi2.y;
                            o[mt] = MFMA32(__builtin_bit_cast(bf16x8, w), pb, o[mt]);
                        }
                    }
            }
            const float sc = gt0 * inv;
#pragma unroll
            for (int i = 0; i < 16; ++i) { TOT[i * 64] = sc * o[0][i]; TOT[(16 + i) * 64] = sc * o[1][i]; }
        }
        __syncthreads();
        {
            const int tok = tid >> 3, jg = tid & 7, cur = qt;
            float v[32];
#pragma unroll
            for (int q = 0; q < 8; ++q) {
                const f32x4 a0 = *(const LAS f32x4*)(PSL + (0 * 64 + tok) * 36 + 4 * q), a1 = *(const LAS f32x4*)(PSL + (1 * 64 + tok) * 36 + 4 * q);
                const f32x4 a2 = *(const LAS f32x4*)(PSL + (2 * 64 + tok) * 36 + 4 * q), a3 = *(const LAS f32x4*)(PSL + (3 * 64 + tok) * 36 + 4 * q);
#pragma unroll
                for (int e = 0; e < 4; ++e) v[4 * q + e] = (a0[e] + a1[e]) + (a2[e] + a3[e]);
            }
            const unsigned forced = 1u | (1u << cur) | (cur > 0 ? (1u << (cur - 1)) : 0u);
            const int need = 8 - __popc(forced);
            unsigned bits = 0u;
#pragma unroll
            for (int e = 0; e < 4; ++e) {
                float mine = 0.f;
#pragma unroll
                for (int q = 0; q < 8; ++q) mine = (jg == q) ? v[4 * q + e] : mine;
                const int j = 4 * jg + e;
                int rank = 0;
#pragma unroll
                for (int jp = 1; jp < 30; ++jp) { const bool cand = jp <= cur - 2; const bool ahead = (v[jp] > mine) || (v[jp] == mine && jp < j); rank += (cand && ahead) ? 1 : 0; }
                if (j >= 1 && j <= cur - 2 && rank < need) bits |= 1u << j;
            }
            bits |= __shfl_xor(bits, 1); bits |= __shfl_xor(bits, 2); bits |= __shfl_xor(bits, 4);
            if (jg == 0) SEL[tok] = forced | bits;
        }
        __syncthreads();
        const unsigned selm = SEL[th * 32 + ql];
        {
            f32x16 o[2]; float l;
            u32x4 kst[2], vst[2];
            attn_first_load<0>(KN + (size_t)((0 * 32 + b) * 4 + g) * SEQ * 64, VTg + (size_t)((0 * 32 + b) * 4 + g) * 64 * SEQ, qt, tid, kst, vst);
            attn_loop<0>(lds, KN + (size_t)((0 * 32 + b) * 4 + g) * SEQ * 64, VTg + (size_t)((0 * 32 + b) * 4 + g) * 64 * SEQ, qt, tq, selm, qf, biasr, sh_slc, o, l, tid, ql, hi, kst, vst);
            attn_first_load<1>(KN + (size_t)((1 * 32 + b) * 4 + g) * SEQ * 64, VTg + (size_t)((1 * 32 + b) * 4 + g) * 64 * SEQ, qt, tid, kst, vst);
            const float sc = gt1 / l;
#pragma unroll
            for (int i = 0; i < 16; ++i) { TOT[i * 64] += sc * o[0][i]; TOT[(16 + i) * 64] += sc * o[1][i]; }
            attn_loop<1>(lds, KN + (size_t)((1 * 32 + b) * 4 + g) * SEQ * 64, VTg + (size_t)((1 * 32 + b) * 4 + g) * 64 * SEQ, qt, tq, selm, qf, biasr, sh_win, o, l, tid, ql, hi, kst, vst);
            const float sc2 = gt2 / l;
#pragma unroll
            for (int i = 0; i < 16; ++i) { o[0][i] = TOT[i * 64] + sc2 * o[0][i]; o[1][i] = TOT[(16 + i) * 64] + sc2 * o[1][i]; }
            if (u + G < 4096) ATT_QLOAD(u + G);
            LAS unsigned char* ost = lds + AT_TOT + wave * 8192;
            LDS_WAIT();
#pragma unroll
            for (int mt = 0; mt < 2; ++mt)
#pragma unroll
                for (int q4 = 0; q4 < 4; ++q4) { u32x2 w; w.x = pk2(o[mt][4 * q4], o[mt][4 * q4 + 1]); w.y = pk2(o[mt][4 * q4 + 2], o[mt][4 * q4 + 3]); *(LAS u32x2*)(ost + ql * AT_STRIDE + (32 * mt + 8 * q4 + 4 * hi) * 2) = w; }
            LDS_WAIT();
            bf16* op = Ob + (size_t)(b * SEQ + qt * 64 + th * 32) * DM + h * 64;
#pragma unroll
            for (int it = 0; it < 4; ++it) { const int row = it * 8 + (lane >> 3), ch = lane & 7; const u32x4 w = *(const LAS u32x4*)(ost + row * AT_STRIDE + ch * 16); *(u32x4*)(op + (size_t)row * DM + ch * 8) = w; }
            LDS_WAIT();
        }
    }
}
#define XB_TMO      128
#define XB_XCNT(j)  (256  + 64 * (j))
#define XB_XSUB(j)  (1280 + 64 * (j))
#define XB_XGEN(j)  (2304 + 64 * (j))
#define XB_TOP      3328
#define XB_TOPGEN   3392
#define XCD_BAR_WORDS 3456
#define XB_SPIN_CAP (1u << 18)

__device__ __forceinline__ unsigned xb_ld(unsigned* p)              { return __hip_atomic_load(p, __ATOMIC_RELAXED, __HIP_MEMORY_SCOPE_AGENT); }
__device__ __forceinline__ unsigned xb_add(unsigned* p, unsigned v) { return __hip_atomic_fetch_add(p, v, __ATOMIC_RELAXED, __HIP_MEMORY_SCOPE_AGENT); }
__device__ __forceinline__ unsigned xb_xcc_id() { return (unsigned)__builtin_amdgcn_s_getreg((3 << 11) | 20) & 0xFu; }
#define XB_SPIN(cond, bar) do { unsigned _sp = 0; while (cond) { __builtin_amdgcn_s_sleep(1); \
    if ((++_sp & 255u) == 0u) { if (xb_ld(&(bar)[XB_TMO])) break; if (_sp > XB_SPIN_CAP) { atomicAdd(&(bar)[XB_TMO], 1u); break; } } } } while (0)

struct XcdBarrier {
    unsigned* bar; unsigned x;
    volatile LAS unsigned* st;
};

__device__ __forceinline__ XcdBarrier xcd_barrier_post(unsigned* bar, volatile LAS unsigned* st) {
    XcdBarrier b; b.bar = bar; b.x = xb_xcc_id(); b.st = st;
    if (threadIdx.x == 0) (void)xb_add(&bar[XB_XCNT(b.x)], 1u);
    return b;
}
__device__ __forceinline__ void xcd_barrier_complete(unsigned* bar, unsigned x, unsigned& nloc, unsigned& nx) {
    const unsigned G = gridDim.x * gridDim.y * gridDim.z;
    unsigned sum, cnt, mine, sp = 0u;
    for (;;) {
        sum = 0u; cnt = 0u; mine = 0u;
#pragma unroll
        for (unsigned j = 0; j < 16; ++j) { const unsigned c = xb_ld(&bar[XB_XCNT(j)]); sum += c; cnt += (c > 0u) ? 1u : 0u; mine = (j == x) ? c : mine; }
        if (sum == G) break;
        __builtin_amdgcn_s_sleep(1);
        if ((++sp & 255u) == 0u) { if (xb_ld(&bar[XB_TMO])) break; if (sp > XB_SPIN_CAP) { atomicAdd(&bar[XB_TMO], 1u); break; } }
    }
    nloc = mine > 0u ? mine : 1u; nx = cnt > 0u ? cnt : 1u;
}

__device__ __forceinline__ void xcd_barrier(const XcdBarrier& b) {
    asm volatile("s_waitcnt vmcnt(0)" ::: "memory");
    __syncthreads();
    if (threadIdx.x == 0) {
        unsigned* bar = b.bar;
        __builtin_amdgcn_s_waitcnt(0);
        unsigned nloc = b.st[0], nx = b.st[1];
        if (nloc == 0u) { xcd_barrier_complete(bar, b.x, nloc, nx); b.st[0] = nloc; b.st[1] = nx; }
        const unsigned old = xb_add(&bar[XB_XSUB(b.x)], 1u);
        const unsigned gen = old / nloc;
        if (old + 1u == (gen + 1u) * nloc) {
            __builtin_amdgcn_fence(__ATOMIC_RELEASE, "agent");
            asm volatile("s_waitcnt vmcnt(0)" ::: "memory");
            const unsigned og = xb_add(&bar[XB_TOP], 1u);
            const unsigned tg = og / nx;
            if (og + 1u == (tg + 1u) * nx) xb_add(&bar[XB_TOPGEN], 1u);
            else XB_SPIN(xb_ld(&bar[XB_TOPGEN]) == tg, bar);
            __builtin_amdgcn_fence(__ATOMIC_ACQUIRE, "agent");
            xb_add(&bar[XB_XGEN(b.x)], 1u);
            asm volatile("s_waitcnt vmcnt(0)" ::: "memory");
        } else {
            XB_SPIN(xb_ld(&bar[XB_XGEN(b.x)]) == gen, bar);
            __builtin_amdgcn_fence(__ATOMIC_ACQUIRE, "agent");
            asm volatile("s_waitcnt vmcnt(0)" ::: "memory");
        }
    }
    __syncthreads();
}

__global__ void __launch_bounds__(512, 2) yoco_fwd(Args a_unused) {
    extern __shared__ __attribute__((aligned(16))) unsigned char lds_raw[];
    LAS unsigned char* lds = (LAS unsigned char*)lds_raw;
    KArgs ap = (KArgs)__builtin_amdgcn_kernarg_segment_ptr();
    const int ph_lo = ap->ph_lo, ph_hi = ap->ph_hi;
    if (threadIdx.x < 2) ((LAS unsigned*)(lds + MISC_OFF))[threadIdx.x] = 0u;
    __syncthreads();
    (void)xcd_barrier_post((unsigned*)(ap->ws + WS_BAR), (volatile LAS unsigned*)(lds + MISC_OFF));
    if (ph_lo < 0) cg::this_grid().sync();
    for (int pi = ph_lo; pi < ph_hi; ++pi) {
        asm volatile("" : "+s"(ap));
        const int code = ap->seq[pi];
        const int kind = code & 15, f = (code >> 4) & 3, half = (code >> 6) & 1, nobar = code >> 7;
        int tid = threadIdx.x; asm volatile("" : "+v"(tid));
        int G = gridDim.x, bx = blockIdx.x; asm volatile("" : "+s"(G), "+s"(bx));
        const int lane = tid & 63, wave = __builtin_amdgcn_readfirstlane(tid >> 6);
        const int vcu = (G % 8 == 0) ? (bx % 8) * (G / 8) + bx / 8 : bx;
        const int gw = vcu * 8 + wave, NGW = G * 8;
        unsigned char* ws = ap->ws;
        bf16* HB = (bf16*)(ws + WS_HB); bf16* HID = (bf16*)(ws + WS_HID);
        switch (kind) {
        case 0: p0_prologue(ap, lds, vcu, G, wave, lane, tid); break;
        case 1: {
            const int rpi = f == 0 ? 0 : (f == 1 ? 2 : (f == 2 ? 3 : 5));
            pg8::Gemm g{HB, (const bf16*)(ws + WS_WIN + (size_t)f * 11 * MiB), NT / 2, 2 * FF, DM}; pg8::StaticOrder S; S.init(NT / 2, 2 * FF, G, bx, half * (NT / 512));
            pg8::EpiSwiglu E{HID, FF, (const float*)(ws + WS_RP + (size_t)rpi * 4 * MiB)};
            pg8::gemm_phase<pg8::EpiSwiglu, pg8::StaticOrder, true, true>(lds, g, S, E, tid);
        } break;
        case 2: case 9: {
            pg8::Gemm g; float scale = 0.5f; int rpo = 1; pg8::StaticOrder S;
            if (kind == 9) { g = pg8::Gemm{(const bf16*)(ws + WS_O), (const bf16*)(ws + WS_WO), NT, DM, DM}; scale = 1.0f; rpo = 5; S.init(NT, DM, G, bx); }
            else { rpo = f == 0 ? 1 : (f == 1 ? 3 : 4); g = pg8::Gemm{HID, (const bf16*)(ws + WS_WOUT + (size_t)f * (11 * MiB / 2)), NT / 2, DM, FF, 1}; S.init(NT / 2, DM, G, bx, half * (NT / 512)); }
            pg8::EpiResid E{HB, (float*)(ws + WS_RP + (size_t)rpo * 4 * MiB), ap->out, scale, (kind == 2 && f == 3) ? 1 : 0, (LAS float*)(lds + 131072), tid};
            pg8::gemm_phase<pg8::EpiResid, pg8::StaticOrder, true, true>(lds, g, S, E, tid);
        } break;
        case 3: s5_phase(ap, lds, vcu, G, wave, lane, tid); break;
        case 4: {
            pg8::Gemm g{(const bf16*)(ws + WS_Z), (const bf16*)(ws + WS_WGLU), NT, DM, DM}; pg8::StaticOrder S; S.init(NT, DM, G, bx);
            pg8::EpiGlu E{HB, (const bf16*)(ws + WS_Z), (float*)(ws + WS_RP + 2 * 4 * MiB), (LAS float*)(lds + 131072), tid};
            pg8::gemm_phase<pg8::EpiGlu, pg8::StaticOrder, true, true>(lds, g, S, E, tid);
        } break;
        case 5: {
            pg8::Gemm g{HB, (const bf16*)(ws + WS_WKV), NT, 1536, DM}; pg8::StaticOrder S; S.init(NT, 1536, G, bx);
            pg8::EpiPlain E{(bf16*)(ws + WS_KV), NT, (const float*)(ws + WS_RP + 3 * 4 * MiB)};
            pg8::gemm_phase<pg8::EpiPlain, pg8::StaticOrder, true, true>(lds, g, S, E, tid);
        } break;
        case 6: {
            kvpost_phase(ap, lds, gw, NGW, wave, lane);
            compress_phase(ap, lds, vcu, G, wave, lane);
            __syncthreads();
        } break;
        case 7: {
            pg8::Gemm g{HB, (const bf16*)(ws + WS_WQG), NT, 1280, DM}; pg8::StaticOrder S; S.init(NT, 1280, G, bx);
            pg8::EpiQG E{(bf16*)(ws + WS_Q), (float*)(ws + WS_GATES), (const float*)(ws + WS_RP + 4 * 4 * MiB)};
            pg8::gemm_phase<pg8::EpiQG, pg8::StaticOrder, true, true>(lds, g, S, E, tid);
        } break;
        case 8: attn_phase(ap, lds, vcu, G, wave, lane, tid); break;
        default: break;
        }
        if (!nobar && pi + 1 < ph_hi) { XcdBarrier xb; xb.bar = (unsigned*)(ap->ws + WS_BAR); xb.x = xb_xcc_id(); xb.st = (volatile LAS unsigned*)(lds + MISC_OFF); xcd_barrier(xb); }
    }
}

#ifndef N_LAUNCH_MODE
#define N_LAUNCH_MODE 0
#endif
extern "C" void kernel_launch(void* const* d_in, const int* in_sizes, int n_in, void* d_out, int out_size, void* d_ws, size_t ws_size, hipStream_t stream) {
    static int grid = 0;
    if (grid == 0) {
        if (n_in != 32 || out_size != NT * DM || ws_size < WS_END) { fprintf(stderr, "kernel_launch: unexpected shapes (n_in %d out %d ws %zu)\n", n_in, out_size, ws_size); grid = -1; return; }
        int dev = 0, cus = 0, per_cu = 0;
        hipGetDevice(&dev); hipDeviceGetAttribute(&cus, hipDeviceAttributeMultiprocessorCount, dev);
        if (hipFuncSetAttribute((const void*)yoco_fwd, hipFuncAttributeMaxDynamicSharedMemorySize, LDS_BYTES) != hipSuccess) { fprintf(stderr, "kernel_launch: hipFuncSetAttribute failed\n"); grid = -1; return; }
        if (hipOccupancyMaxActiveBlocksPerMultiprocessor(&per_cu, (const void*)yoco_fwd, 512, LDS_BYTES) != hipSuccess || per_cu < 1) { fprintf(stderr, "kernel_launch: occupancy query gave %d\n", per_cu); per_cu = 1; }
        (void)hipGetLastError();
        grid = cus * per_cu;
        if (grid > 256) grid = 256;
    }
    if (grid < 0) return;
#ifndef PROBE_MASK
#define PROBE_MASK 0u
#endif
    if (hipMemsetAsync((char*)d_ws + WS_BAR, 0, 16384, stream) != hipSuccess) { fprintf(stderr, "kernel_launch: memset of barrier words failed\n"); return; }
    static Args as[NPHASE + 1];
    unsigned char seq[32]; int nseq = 0;
    auto T = [&](int kind, int f, int half, int nobar) { seq[nseq++] = (unsigned char)(kind | (f << 4) | (half << 6) | (nobar << 7)); };
    T(0, 0, 0, 0);
    T(1, 0, 0, 0); T(2, 0, 0, 1); T(1, 0, 1, 0); T(2, 0, 1, 0);
    T(3, 0, 0, 0); T(4, 0, 0, 0);
    T(1, 1, 0, 0); T(2, 1, 0, 1); T(1, 1, 1, 0); T(2, 1, 1, 0);
    T(5, 0, 0, 1); T(1, 2, 0, 0);
    T(6, 0, 0, 1); T(2, 2, 0, 1); T(1, 2, 1, 0); T(2, 2, 1, 0);
    T(7, 0, 0, 0); T(8, 0, 0, 0); T(9, 0, 0, 0);
    T(1, 3, 0, 0); T(2, 3, 0, 1); T(1, 3, 1, 0); T(2, 3, 1, 0);
    for (int p = nseq; p < 32; ++p) seq[p] = 255;
    for (int li = 0; li < (N_LAUNCH_MODE ? NPHASE : 1); ++li) {
        Args& a = as[li]; a = Args{};
        for (int i = 0; i < 32; ++i) a.in[i] = (const float*)d_in[i];
        a.out = (float*)d_out; a.ws = (unsigned char*)d_ws;
        a.ph_lo = N_LAUNCH_MODE ? li : 0; a.ph_hi = N_LAUNCH_MODE ? li + 1 : nseq;
        for (int p = 0; p < 32; ++p) a.seq[p] = seq[p];
        void* args[] = {&a};
        hipError_t e = hipLaunchCooperativeKernel((const void*)yoco_fwd, dim3(grid), dim3(512), args, LDS_BYTES, stream);
        if (e != hipSuccess) { fprintf(stderr, "cooperative launch %d failed: %s (grid %d)\n", li, hipGetErrorString(e), grid); break; }
    }
}
```
